# Optimizing an MI355X kernel written in HIP

```python
import jax, jax.numpy as jnp
from jax import lax
import numpy as np

D_MODEL = 1024
BATCH = 8
SEQ = 4096
DEPTH = 1

MEM_LEN = 256
CONV_WIDTH = D_MODEL // 2
CONV_K = 3
ATT_HEADS = 8
HEAD_DIM = 64
ATT_WIDTH = ATT_HEADS * HEAD_DIM
KV_GROUPS = 2
Q_PER_KV = ATT_HEADS // KV_GROUPS
KV_WIDTH = KV_GROUPS * HEAD_DIM
MIX_WIDTH = CONV_WIDTH + ATT_WIDTH
CMP_BLOCK = 32
CMP_STRIDE = 16
CMP_HIDDEN = 256
SLC_BLOCK = 64
N_SELECT = 16
WINDOW = 512
Q_BLOCK = 128
ROPE_THETA = 10000.0
X_HEADS = 4
X_HEAD_DIM = D_MODEL // X_HEADS
D_FF = -(-8 * D_MODEL // (3 * 256)) * 256
EPS = 1e-6
FORCE = 1e4
W_IN_COLS = 3 * CONV_WIDTH + ATT_WIDTH + 6 * KV_WIDTH + 3 * ATT_HEADS

kernel_name = "hymba_conv_nsa_sandwich_block"


def rmsnorm(x, g):
    xf = x.astype(jnp.float32)
    y = xf * lax.rsqrt(jnp.mean(xf * xf, axis=-1, keepdims=True) + EPS)
    return (y * g.astype(jnp.float32)).astype(x.dtype)


def rope(x, pos):
    half = HEAD_DIM // 2
    inv = ROPE_THETA ** (-jnp.arange(half, dtype=jnp.float32) / half)
    ang = pos.astype(jnp.float32)[..., None] * inv
    cos = jnp.cos(ang)[:, :, None, :]
    sin = jnp.sin(ang)[:, :, None, :]
    xf = x.astype(jnp.float32)
    x1, x2 = xf[..., :half], xf[..., half:]
    return jnp.concatenate([x1 * cos - x2 * sin, x2 * cos + x1 * sin], axis=-1).astype(x.dtype)


def masked_softmax(s, mask):
    s = jnp.where(mask, s.astype(jnp.float32), -1e30)
    e = jnp.exp(s - jnp.max(s, axis=-1, keepdims=True)) * mask
    return e / jnp.maximum(jnp.sum(e, axis=-1, keepdims=True), 1e-30)


def compress(k, pe, w1, w2, n_cmp):
    b = k.shape[0]
    idx = np.arange(n_cmp)[:, None] * CMP_STRIDE + np.arange(CMP_BLOCK)[None, :]
    blocks = k[:, idx] + pe[None, None, :, None, :]
    flat = blocks.transpose(0, 1, 3, 2, 4).reshape(b, n_cmp, KV_GROUPS, CMP_BLOCK * HEAD_DIM)
    return jax.nn.silu(flat @ w1) @ w2


def short_conv_mixer(bg, cg, xin, conv_w):
    z = cg * xin
    zc = lax.conv_general_dilated(z, conv_w[:, None, :].astype(z.dtype), window_strides=(1,),
                                  padding=((CONV_K - 1, 0),), dimension_numbers=("NWC", "WIO", "NWC"),
                                  feature_group_count=CONV_WIDTH)
    return bg * zc


def nsa_mixer(q, k_cmp_raw, v_cmp_raw, k_slc, v_slc, k_win, v_win, gates, positions,
              pe_kc, w1_kc, w2_kc, pe_vc, w1_vc, w2_vc):
    b, s = q.shape[0], q.shape[1]
    n_cmp = (s - CMP_BLOCK) // CMP_STRIDE + 1
    n_slc = s // SLC_BLOCK
    n_sel = min(N_SELECT, n_slc)
    scale = HEAD_DIM ** -0.5

    q = rope(q, positions)
    cmp_end_np = np.arange(n_cmp) * CMP_STRIDE + CMP_BLOCK - 1
    cmp_end = jnp.asarray(cmp_end_np, dtype=jnp.int32)
    k_cmp = rope(compress(k_cmp_raw, pe_kc, w1_kc, w2_kc, n_cmp), positions[:, cmp_end_np])
    v_cmp = compress(v_cmp_raw, pe_vc, w1_vc, w2_vc, n_cmp)

    ci = np.arange(n_cmp)[:, None] * CMP_STRIDE
    sj = np.arange(n_slc)[None, :] * SLC_BLOCK
    ov = np.clip(np.minimum(ci + CMP_BLOCK, sj + SLC_BLOCK) - np.maximum(ci, sj), 0, None)
    slc_map = jnp.asarray(ov / CMP_BLOCK, dtype=jnp.float32)

    k_blocks = rope(k_slc, positions).reshape(b, n_slc, SLC_BLOCK, KV_GROUPS, HEAD_DIM).transpose(0, 3, 1, 2, 4)
    v_blocks = v_slc.reshape(b, n_slc, SLC_BLOCK, KV_GROUPS, HEAD_DIM).transpose(0, 3, 1, 2, 4)
    pad = ((0, 0), (WINDOW, 0), (0, 0), (0, 0))
    k_win_pad = jnp.pad(rope(k_win, positions), pad)
    v_win_pad = jnp.pad(v_win, pad)
    bi = jnp.arange(b)[:, None, None, None]
    gi = jnp.arange(KV_GROUPS)[None, :, None, None]
    blk = jnp.arange(n_slc)

    def block(i):
        s0 = i * Q_BLOCK
        t = s0 + jnp.arange(Q_BLOCK)
        qb = lax.dynamic_slice_in_dim(q, s0, Q_BLOCK, axis=1).reshape(b, Q_BLOCK, KV_GROUPS, Q_PER_KV, HEAD_DIM)
        gb = lax.dynamic_slice_in_dim(gates, s0, Q_BLOCK, axis=1).reshape(b, Q_BLOCK, KV_GROUPS, Q_PER_KV, 3)

        s_c = jnp.einsum("bqgrd,bkgd->bgrqk", qb, k_cmp) * scale
        p_c = masked_softmax(s_c, cmp_end[None, :] <= t[:, None])
        o_c = jnp.einsum("bgrqk,bkgd->bqgrd", p_c, v_cmp)

        imp = jnp.einsum("bgrqk,ks->bgqs", p_c, slc_map)
        cur = t // SLC_BLOCK
        forced = (blk[None, :] == 0) | (blk[None, :] == cur[:, None]) | (blk[None, :] == cur[:, None] - 1)
        future = blk[None, :] * SLC_BLOCK > t[:, None]
        imp = jnp.where(forced, FORCE, jnp.where(future, -FORCE, imp))
        _, sel = lax.top_k(imp, n_sel)
        ks = k_blocks[bi, gi, sel].reshape(b, KV_GROUPS, Q_BLOCK, n_sel * SLC_BLOCK, HEAD_DIM)
        vs = v_blocks[bi, gi, sel].reshape(b, KV_GROUPS, Q_BLOCK, n_sel * SLC_BLOCK, HEAD_DIM)
        kpos = (sel[..., None] * SLC_BLOCK + jnp.arange(SLC_BLOCK)).reshape(b, KV_GROUPS, Q_BLOCK, n_sel * SLC_BLOCK)
        s_s = jnp.einsum("bqgrd,bgqkd->bgrqk", qb, ks) * scale
        p_s = masked_softmax(s_s, (kpos <= t[None, None, :, None])[:, :, None])
        o_s = jnp.einsum("bgrqk,bgqkd->bqgrd", p_s, vs)

        kw = lax.dynamic_slice_in_dim(k_win_pad, s0, Q_BLOCK + WINDOW, axis=1)
        vw = lax.dynamic_slice_in_dim(v_win_pad, s0, Q_BLOCK + WINDOW, axis=1)
        wpos = s0 - WINDOW + jnp.arange(Q_BLOCK + WINDOW)
        mask_w = (wpos[None, :] <= t[:, None]) & (wpos[None, :] > t[:, None] - WINDOW) & (wpos[None, :] >= 0)
        s_w = jnp.einsum("bqgrd,bkgd->bgrqk", qb, kw) * scale
        p_w = masked_softmax(s_w, mask_w)
        o_w = jnp.einsum("bgrqk,bkgd->bqgrd", p_w, vw)

        o = gb[..., 0:1] * o_c + gb[..., 1:2] * o_s + gb[..., 2:3] * o_w
        return o.reshape(b, Q_BLOCK, ATT_WIDTH).astype(q.dtype)

    out = lax.map(block, jnp.arange(s // Q_BLOCK))
    return out.transpose(1, 0, 2, 3).reshape(b, s, ATT_WIDTH)


def setup_inputs(seed: int = 0) -> dict:
    key = jax.random.key(seed)
    ks = jax.random.split(key, 32)

    def w(k, shape, fan_in):
        return jax.random.normal(k, shape, jnp.float32) * fan_in ** -0.5

    def gain(k, n):
        return 1.0 + 0.05 * jax.random.normal(k, (n,), jnp.float32)

    offs = jax.random.randint(ks[2], (BATCH, 1), 0, 2048, dtype=jnp.int32)
    return {
        "x": jax.random.normal(ks[0], (BATCH, SEQ, D_MODEL), jnp.float32),
        "mem": jax.random.normal(ks[1], (BATCH, MEM_LEN, D_MODEL), jnp.float32),
        "positions": jnp.arange(SEQ, dtype=jnp.int32)[None, :] + offs,
        "norm_mix_pre": gain(ks[3], D_MODEL),
        "w_in": w(ks[4], (D_MODEL, W_IN_COLS), D_MODEL),
        "conv_w": w(ks[5], (CONV_K, CONV_WIDTH), CONV_K),
        "pe_kc": 0.1 * jax.random.normal(ks[6], (CMP_BLOCK, HEAD_DIM), jnp.float32),
        "w1_kc": w(ks[7], (CMP_BLOCK * HEAD_DIM, CMP_HIDDEN), CMP_BLOCK * HEAD_DIM),
        "w2_kc": w(ks[8], (CMP_HIDDEN, HEAD_DIM), CMP_HIDDEN),
        "pe_vc": 0.1 * jax.random.normal(ks[9], (CMP_BLOCK, HEAD_DIM), jnp.float32),
        "w1_vc": w(ks[10], (CMP_BLOCK * HEAD_DIM, CMP_HIDDEN), CMP_BLOCK * HEAD_DIM),
        "w2_vc": w(ks[11], (CMP_HIDDEN, HEAD_DIM), CMP_HIDDEN),
        "norm_conv_out": gain(ks[12], CONV_WIDTH),
        "norm_attn_out": gain(ks[13], ATT_WIDTH),
        "w_out": w(ks[14], (MIX_WIDTH, D_MODEL), MIX_WIDTH),
        "norm_mix_post": gain(ks[15], D_MODEL),
        "norm_x_pre": gain(ks[16], D_MODEL),
        "norm_mem": gain(ks[17], D_MODEL),
        "w_q_x": w(ks[18], (D_MODEL, D_MODEL), D_MODEL),
        "w_kv_x": w(ks[19], (D_MODEL, 2 * D_MODEL), D_MODEL),
        "w_o_x": w(ks[20], (D_MODEL, D_MODEL), D_MODEL),
        "norm_x_post": gain(ks[21], D_MODEL),
        "norm_ffn_pre": gain(ks[22], D_MODEL),
        "w_gate_up": w(ks[23], (D_MODEL, 2 * D_FF), D_MODEL),
        "w_down": w(ks[24], (D_FF, D_MODEL), D_FF),
        "norm_ffn_post": gain(ks[25], D_MODEL),
    }


def reference(x, mem, positions, norm_mix_pre, w_in, conv_w, pe_kc, w1_kc, w2_kc, pe_vc, w1_vc, w2_vc,
              norm_conv_out, norm_attn_out, w_out, norm_mix_post, norm_x_pre, norm_mem, w_q_x, w_kv_x,
              w_o_x, norm_x_post, norm_ffn_pre, w_gate_up, w_down, norm_ffn_post):
    b, s, _ = x.shape
    h = x
    for _layer in range(DEPTH):
        u = rmsnorm(h, norm_mix_pre)
        proj = u @ w_in
        cuts = np.cumsum([CONV_WIDTH, CONV_WIDTH, CONV_WIDTH, ATT_WIDTH] + [KV_WIDTH] * 6)
        bg, cg, xin, q, kc, vc, ksl, vsl, kw, vw, gl = jnp.split(proj, cuts, axis=-1)
        kv_shape = (b, s, KV_GROUPS, HEAD_DIM)
        y_conv = short_conv_mixer(bg, cg, xin, conv_w)
        y_att = nsa_mixer(q.reshape(b, s, ATT_HEADS, HEAD_DIM), kc.reshape(kv_shape), vc.reshape(kv_shape),
                          ksl.reshape(kv_shape), vsl.reshape(kv_shape), kw.reshape(kv_shape), vw.reshape(kv_shape),
                          jax.nn.sigmoid(gl).reshape(b, s, ATT_HEADS, 3), positions,
                          pe_kc, w1_kc, w2_kc, pe_vc, w1_vc, w2_vc)
        mixed = jnp.concatenate([rmsnorm(y_conv, norm_conv_out), rmsnorm(y_att, norm_attn_out)], axis=-1)
        h = h + rmsnorm(mixed @ w_out, norm_mix_post)

        hn = rmsnorm(h, norm_x_pre)
        mn = rmsnorm(mem, norm_mem)
        qx = (hn @ w_q_x).reshape(b, s, X_HEADS, X_HEAD_DIM)
        kx, vx = jnp.split(mn @ w_kv_x, 2, axis=-1)
        kx = kx.reshape(b, MEM_LEN, X_HEADS, X_HEAD_DIM)
        vx = vx.reshape(b, MEM_LEN, X_HEADS, X_HEAD_DIM)
        sx = jnp.einsum("bshd,bmhd->bhsm", qx, kx).astype(jnp.float32) * X_HEAD_DIM ** -0.5
        px = jax.nn.softmax(sx, axis=-1)
        ox = jnp.einsum("bhsm,bmhd->bshd", px, vx).astype(h.dtype).reshape(b, s, D_MODEL)
        h = h + rmsnorm(ox @ w_o_x, norm_x_post)

        hn = rmsnorm(h, norm_ffn_pre)
        g, up = jnp.split(hn @ w_gate_up, 2, axis=-1)
        h = h + rmsnorm((jax.nn.silu(g) * up) @ w_down, norm_ffn_post)
    return h
```

```cpp
#include <hip/hip_runtime.h>
#include <hip/hip_bf16.h>
#include <cstdio>
#include <cstdint>
#include <cmath>
namespace pg8 {
#define PG8_LAS __attribute__((address_space(3)))
typedef unsigned short bf16_t;
typedef short bf16x8 __attribute__((ext_vector_type(8)));
typedef float f32x4 __attribute__((ext_vector_type(4)));
typedef unsigned u32x4 __attribute__((ext_vector_type(4)));
constexpr int BM = 256, BK = 64, HALF = 128, HTB = HALF * BK * 2  , STAGE_BYTES = 8 * HTB, NXCD = 8, WGM = 8;

__host__ __device__ __forceinline__ int lds_byte(int r, int c) { const int st = (r >> 4) * 2 + (c >> 5), rr = r & 15, cc = c & 31, ob = rr * 64 + cc * 2; return st * 1024 + (ob ^ (((ob >> 9) & 1) << 5)); }
__host__ __device__ __forceinline__ void stage_rc(int b, int& R, int& C) { const int st = b / 1024, sb = b % 1024, swz = sb ^ (((sb >> 9) & 1) << 5); R = (st >> 1) * 16 + swz / 64; C = (st & 1) * 32 + (swz % 64) / 2; }
__host__ __device__ __forceinline__ int perm32(int rho) { const int n = rho >> 4, i = rho & 15; return 8 * (i >> 2) + 4 * n + (i & 3); }

struct Unit { int pm, pn; };
struct Gemm { const bf16_t* A; const bf16_t* Bt; int M, N, K; };

struct StaticOrder {
    int nM, nN, nwg, G, c;
    __host__ __device__ void init(int M, int N, int G_, int c_) { nM = M / BM; nN = N / BM; nwg = nM * nN; G = G_; c = c_; }
    __host__ __device__ bool next(int i, Unit& u) const {
        const long L = (long)i * G + c; if (L >= nwg) return false;
        int wgid = (int)L; { const int q = nwg / NXCD, r = nwg % NXCD, xcd = wgid % NXCD, off = wgid / NXCD; wgid = (xcd < r ? xcd * (q + 1) : r * (q + 1) + (xcd - r) * q) + off; }
        const int nig = WGM * nN, gid = wgid / nig, fm = gid * WGM, gsz = (nM - fm) < WGM ? (nM - fm) : WGM;
        u.pm = fm + ((wgid % nig) % gsz); u.pn = (wgid % nig) / gsz; return true;
    }
    __device__ __forceinline__ void a_ready(const Unit&) const {}
    __device__ __forceinline__ void done(const Unit&) const {}
};

__device__ __forceinline__ unsigned cvt_pk_bf16(float lo, float hi) { unsigned r; asm volatile("v_cvt_pk_bf16_f32 %0, %1, %2" : "=v"(r) : "v"(lo), "v"(hi)); return r; }
struct EpiStore {
    static constexpr bool PERM = true, AFTER_DRAIN = false;
    bf16_t* O; int ldc; float scale;
    __device__ __forceinline__ void operator()(const f32x4 (&acc)[2][2][4][2], const Unit& u, int wr, int wc, int fr, int fq) const {
        const int row0 = u.pm * BM + wr * 64 + fr; const int col0 = u.pn * BM + wc * 32 + 8 * fq; const float sc = scale;
#pragma unroll
        for (int ai = 0; ai < 2; ++ai)
#pragma unroll
            for (int m = 0; m < 4; ++m) { bf16_t* rowp = O + (size_t)(row0 + ai * HALF + m * 16) * ldc + col0;
#pragma unroll
                for (int bj = 0; bj < 2; ++bj) { const f32x4 v0 = acc[ai][bj][m][0] * sc, v1 = acc[ai][bj][m][1] * sc;
                    u32x4 w; w.x = cvt_pk_bf16(v0[0], v0[1]); w.y = cvt_pk_bf16(v0[2], v0[3]); w.z = cvt_pk_bf16(v1[0], v1[1]); w.w = cvt_pk_bf16(v1[2], v1[3]);
                    *(u32x4*)(rowp + bj * HALF) = w; } }
    }
};
__device__ __forceinline__ float silu_f(float x) { return x * __builtin_amdgcn_rcpf(1.0f + __builtin_amdgcn_exp2f(-1.4426950408889634f * x)); }
struct EpiSwiGLU {
    static constexpr bool PERM = true, AFTER_DRAIN = false;
    bf16_t* O; int ldc;
    __device__ __forceinline__ void operator()(const f32x4 (&acc)[2][2][4][2], const Unit& u, int wr, int wc, int fr, int fq) const {
        const int row0 = u.pm * BM + wr * 64 + fr; const int col0 = u.pn * HALF + wc * 32 + 8 * fq;
#pragma unroll
        for (int ai = 0; ai < 2; ++ai)
#pragma unroll
            for (int m = 0; m < 4; ++m) { bf16_t* rowp = O + (size_t)(row0 + ai * HALF + m * 16) * ldc + col0;
                const f32x4 g0 = acc[ai][0][m][0], g1 = acc[ai][0][m][1], u0 = acc[ai][1][m][0], u1 = acc[ai][1][m][1];
                float h[8];
#pragma unroll
                for (int e = 0; e < 4; ++e) { h[e] = silu_f(g0[e]) * u0[e]; h[4 + e] = silu_f(g1[e]) * u1[e]; }
                u32x4 w; w.x = cvt_pk_bf16(h[0], h[1]); w.y = cvt_pk_bf16(h[2], h[3]); w.z = cvt_pk_bf16(h[4], h[5]); w.w = cvt_pk_bf16(h[6], h[7]);
                *(u32x4*)rowp = w; }
    }
};

template <class Epi, class Sched, bool ALIGN_EPI = false, bool SP2 = false>
__device__ __forceinline__ void gemm_phase(PG8_LAS unsigned char* lds, const Gemm g, const Sched& S, const Epi& E) {
    const int tid = threadIdx.x, wid = __builtin_amdgcn_readfirstlane(tid >> 6), lane = tid & 63, wr = wid >> 2, wc = wid & 3, fr = lane & 15, fq = lane >> 4;
    const int K = g.K, nt = K / BK;
    unsigned voffA[2], voffB[2];
#pragma unroll
    for (int i = 0; i < 2; ++i) { int R, C; stage_rc(tid * 16 + i * 8192, R, C); const int Rb = Epi::PERM ? ((R & ~31) + perm32(R & 31)) : R;
        voffA[i] = (unsigned)(R * K + C) * 2u; voffB[i] = (unsigned)(Rb * K + C) * 2u; }
    const size_t kstep = (size_t)(BK * 2);
    const size_t hstep = (size_t)HALF * K * 2;
    const size_t tstep = 2 * hstep;
    const unsigned ldsw = (unsigned)wid * 1024u;
    const int aoff = lds_byte(wr * 64 + fr, fq * 8), boff = lds_byte(wc * 32 + fr, fq * 8);
#define PG8_SA(b, h) (((b) * 2 + (h)) * HTB)
#define PG8_SB(b, h) ((4 + (b) * 2 + (h)) * HTB)
#define PG8_STAGE(bufoff, gbase, voff) do { _Pragma("unroll") for (int _i = 0; _i < 2; ++_i) \
        __builtin_amdgcn_global_load_lds((const unsigned*)((const char*)(gbase) + (voff)[_i]), (PG8_LAS unsigned*)(lds + (bufoff) + ldsw + _i * 8192), 16, 0, 0); } while (0)
#define PG8_LDA(dst, b, h) do { _Pragma("unroll") for (int m = 0; m < 4; ++m) _Pragma("unroll") for (int k = 0; k < 2; ++k) dst[m][k] = *(const PG8_LAS bf16x8*)(lds + PG8_SA(b, h) + aoff + m * 2048 + k * 1024); } while (0)
#define PG8_LDB(dst, b, h) do { _Pragma("unroll") for (int n = 0; n < 2; ++n) _Pragma("unroll") for (int k = 0; k < 2; ++k) dst[n][k] = *(const PG8_LAS bf16x8*)(lds + PG8_SB(b, h) + boff + n * 2048 + k * 1024); } while (0)
#define PG8_MMA(ai, bj, At, Bt) do { __builtin_amdgcn_s_setprio(1); _Pragma("unroll") for (int m = 0; m < 4; ++m) _Pragma("unroll") for (int n = 0; n < 2; ++n) _Pragma("unroll") for (int k = 0; k < 2; ++k) \
        acc[ai][bj][m][n] = __builtin_amdgcn_mfma_f32_16x16x32_bf16(Bt[n][k], At[m][k], acc[ai][bj][m][n], 0, 0, 0); __builtin_amdgcn_s_setprio(0); } while (0)
#define PG8_WAIT_V(n) asm volatile("s_waitcnt vmcnt(" #n ")" ::: "memory")
#define PG8_WAIT_L(n) asm volatile("s_waitcnt lgkmcnt(" #n ")" ::: "memory")
#define PG8_BAR __builtin_amdgcn_s_barrier()
#define PG8_SCHED __builtin_amdgcn_sched_barrier(0)
    Unit cur, nxt; int ui = 0;
    if (!S.next(0, cur)) return;
    f32x4 acc[2][2][4][2];
#pragma unroll
    for (int a = 0; a < 2; ++a)
#pragma unroll
        for (int b = 0; b < 2; ++b)
#pragma unroll
            for (int m = 0; m < 4; ++m)
#pragma unroll
                for (int n = 0; n < 2; ++n) acc[a][b][m][n] = (f32x4){0.f, 0.f, 0.f, 0.f};
    bf16x8 At[4][2], B0[2][2], B1[2][2];
    const char* cA = (const char*)g.A + (size_t)cur.pm * tstep; const char* cB = (const char*)g.Bt + (size_t)cur.pn * tstep;
    S.a_ready(cur);
    if constexpr (SP2) {
        PG8_STAGE(PG8_SB(0, 0), cB, voffB); PG8_STAGE(PG8_SB(0, 1), cB + hstep, voffB); PG8_STAGE(PG8_SA(0, 0), cA, voffA); PG8_STAGE(PG8_SA(0, 1), cA + hstep, voffA);
        if (wr == 1) PG8_BAR;
        PG8_WAIT_V(2); PG8_BAR;
        PG8_STAGE(PG8_SB(1, 0), cB + kstep, voffB); PG8_STAGE(PG8_SA(1, 0), cA + kstep, voffA); PG8_STAGE(PG8_SB(1, 1), cB + hstep + kstep, voffB);
        PG8_WAIT_V(6); PG8_BAR;
    } else {
        PG8_STAGE(PG8_SB(0, 0), cB, voffB); PG8_STAGE(PG8_SA(0, 0), cA, voffA); PG8_STAGE(PG8_SB(0, 1), cB + hstep, voffB); PG8_STAGE(PG8_SA(0, 1), cA + hstep, voffA);
        if (wr == 1) PG8_BAR;
        PG8_WAIT_V(4); PG8_BAR;
        PG8_STAGE(PG8_SB(1, 0), cB + kstep, voffB); PG8_STAGE(PG8_SA(1, 0), cA + kstep, voffA); PG8_STAGE(PG8_SB(1, 1), cB + hstep + kstep, voffB);
        PG8_WAIT_V(6); PG8_BAR;
    }
    for (;;) {
        const bool has_next = S.next(ui + 1, nxt);
        const char* nA = has_next ? (const char*)g.A + (size_t)nxt.pm * tstep : cA; const char* nB = has_next ? (const char*)g.Bt + (size_t)nxt.pn * tstep : cB;
        for (int t = 0; t < nt; t += 2) {
            const bool last = (t == nt - 2);
            const char* a1 = cA + (size_t)(t + 1) * kstep;
            const char* a2 = last ? nA : cA + (size_t)(t + 2) * kstep; const char* b2 = last ? nB : cB + (size_t)(t + 2) * kstep;
            const char* a3 = a2 + kstep; const char* b3 = b2 + kstep;
            if (last && has_next) S.a_ready(nxt);
            if constexpr (SP2) {
            PG8_LDB(B0, 0, 0); PG8_LDB(B1, 0, 1); PG8_SCHED; PG8_LDA(At, 0, 0); PG8_STAGE(PG8_SA(1, 1), a1 + hstep, voffA);
            PG8_WAIT_V(8); PG8_WAIT_L(0); PG8_BAR; PG8_MMA(0, 0, At, B0); PG8_MMA(0, 1, At, B1); PG8_BAR; PG8_SCHED;
            PG8_LDA(At, 0, 1); PG8_STAGE(PG8_SB(0, 0), b2, voffB); PG8_STAGE(PG8_SB(0, 1), b2 + hstep, voffB); PG8_STAGE(PG8_SA(0, 0), a2, voffA);
            PG8_WAIT_V(8); PG8_WAIT_L(0); PG8_BAR; PG8_MMA(1, 0, At, B0); PG8_MMA(1, 1, At, B1); PG8_BAR; PG8_SCHED;
            PG8_LDB(B0, 1, 0); PG8_LDB(B1, 1, 1); PG8_SCHED; PG8_LDA(At, 1, 0); PG8_STAGE(PG8_SA(0, 1), a2 + hstep, voffA);
            PG8_WAIT_V(8); PG8_WAIT_L(0); PG8_BAR; PG8_MMA(0, 0, At, B0); PG8_MMA(0, 1, At, B1); PG8_BAR; PG8_SCHED;
            PG8_LDA(At, 1, 1); PG8_STAGE(PG8_SB(1, 0), b3, voffB); PG8_STAGE(PG8_SB(1, 1), b3 + hstep, voffB); PG8_STAGE(PG8_SA(1, 0), a3, voffA);
            PG8_WAIT_V(8); PG8_WAIT_L(0); PG8_BAR; PG8_MMA(1, 0, At, B0); PG8_MMA(1, 1, At, B1); PG8_BAR; PG8_SCHED;
            } else {
            PG8_LDB(B0, 0, 0); PG8_SCHED; PG8_LDA(At, 0, 0); PG8_STAGE(PG8_SA(1, 1), a1 + hstep, voffA);
            PG8_WAIT_L(8); PG8_BAR; PG8_WAIT_L(0); PG8_MMA(0, 0, At, B0); PG8_BAR; PG8_SCHED;
            PG8_LDB(B1, 0, 1); PG8_STAGE(PG8_SB(0, 0), b2, voffB);
            PG8_BAR; PG8_WAIT_L(0); PG8_MMA(0, 1, At, B1); PG8_BAR;
            PG8_LDA(At, 0, 1); PG8_STAGE(PG8_SA(0, 0), a2, voffA);
            PG8_BAR; PG8_WAIT_L(0); PG8_MMA(1, 0, At, B0); PG8_BAR; PG8_SCHED;
            PG8_STAGE(PG8_SB(0, 1), b2 + hstep, voffB);
            PG8_WAIT_V(6); PG8_BAR; PG8_MMA(1, 1, At, B1); PG8_BAR;
            PG8_LDB(B0, 1, 0); PG8_SCHED; PG8_LDA(At, 1, 0); PG8_STAGE(PG8_SA(0, 1), a2 + hstep, voffA);
            PG8_WAIT_L(8); PG8_BAR; PG8_WAIT_L(0); PG8_MMA(0, 0, At, B0); PG8_BAR; PG8_SCHED;
            PG8_LDB(B1, 1, 1); PG8_STAGE(PG8_SB(1, 0), b3, voffB);
            PG8_BAR; PG8_WAIT_L(0); PG8_MMA(0, 1, At, B1); PG8_BAR;
            PG8_LDA(At, 1, 1); PG8_STAGE(PG8_SA(1, 0), a3, voffA);
            PG8_BAR; PG8_WAIT_L(0); PG8_MMA(1, 0, At, B0); PG8_BAR; PG8_SCHED;
            PG8_STAGE(PG8_SB(1, 1), b3 + hstep, voffB);
            PG8_WAIT_V(6); PG8_BAR; PG8_MMA(1, 1, At, B1); PG8_BAR;
            }
        }
        if constexpr (ALIGN_EPI) { if (wr == 0) PG8_BAR; }
        if constexpr (!Epi::AFTER_DRAIN) { E(acc, cur, wr, wc, fr, fq); S.done(cur); }
        if (!has_next) break;
#pragma unroll
        for (int a = 0; a < 2; ++a)
#pragma unroll
            for (int b = 0; b < 2; ++b)
#pragma unroll
                for (int m = 0; m < 4; ++m)
#pragma unroll
                    for (int n = 0; n < 2; ++n) acc[a][b][m][n] = (f32x4){0.f, 0.f, 0.f, 0.f};
        cur = nxt; cA = nA; cB = nB; ++ui;
        if constexpr (ALIGN_EPI) { if (wr == 1) PG8_BAR; }
    }
    PG8_WAIT_V(0);
    if constexpr (!ALIGN_EPI) { if (wr == 0) PG8_BAR; }
    PG8_BAR;
    if constexpr (Epi::AFTER_DRAIN) { E.fused(acc, cur, wr, wc, fr, fq, lds, wid, lane); S.done(cur); }
#undef PG8_SA
#undef PG8_SB
#undef PG8_STAGE
#undef PG8_LDA
#undef PG8_LDB
#undef PG8_MMA
#undef PG8_WAIT_V
#undef PG8_WAIT_L
#undef PG8_BAR
#undef PG8_SCHED
}
}

constexpr int NWAVES = 8;
constexpr int BATCH = 8, SEQ = 4096, DM = 1024, MTOK = BATCH * SEQ;
constexpr int MEM_LEN = 256, MMEM = BATCH * MEM_LEN;
constexpr int W_IN_COLS = 2840, NPROJ = 3072, DFF = 2816;
constexpr int COL_BG = 0, COL_CG = 512, COL_XIN = 1024, COL_Q = 1536, COL_KC = 2048, COL_VC = 2176, COL_KSL = 2304, COL_VSL = 2432, COL_KW = 2560, COL_VW = 2688, COL_GL = 2816;
constexpr float EPS = 1e-6f;
constexpr float LOG2E = 1.4426950408889634f;
constexpr float C2_NSA = 0.125f * LOG2E;
constexpr float C2_X = 0.0625f * LOG2E;

constexpr size_t MiB = 1u << 20;
constexpr size_t WS_CTL = 0, CTL_ZERO_BYTES = 1 * MiB;
constexpr size_t WS_BIAS = 512 * 1024;
constexpr size_t WS_WIN = 2 * MiB, WS_W1KC = 8 * MiB, WS_W1VC = 9 * MiB, WS_W2KC = 10 * MiB, WS_W2VC = 10 * MiB + 512 * 1024;
constexpr size_t WS_WOUT = 11 * MiB, WS_WQ = 13 * MiB, WS_WKV = 15 * MiB, WS_WO = 19 * MiB, WS_WGU = 21 * MiB, WS_WD = 32 * MiB;
constexpr size_t WS_MN = 38 * MiB, WS_KVX = 42 * MiB, WS_KCMP = 50 * MiB, WS_VCMP = 51 * MiB;
constexpr size_t WS_XN = 64 * MiB, WS_PROJ = 128 * MiB, WS_OX = WS_PROJ, WS_HB = WS_PROJ, WS_MIXED = 320 * MiB, WS_QX = WS_MIXED, WS_Z = 384 * MiB, WS_END = 448 * MiB;
constexpr int CW_BAR = 4096;

constexpr int RING_OFF = 0, RING_BYTES = 131072;
constexpr int WSF_OFF = RING_BYTES;
constexpr int LDSCTL_OFF = WSF_OFF + 2048, MISC_OFF = LDSCTL_OFF + 320;
constexpr int LDS_BYTES = 147456;
static_assert(MISC_OFF + 128 <= LDS_BYTES, "LDS map");
constexpr int NS_K = 0, NS_V = 16384, NS_IMP = 32768, NS_SELM = 49152, NS_YST = 53248;
static_assert(NS_YST + 65536 <= RING_BYTES, "NSA LDS map");

#define GAS __attribute__((address_space(1)))
#define LAS __attribute__((address_space(3)))
typedef unsigned short bf16;
typedef unsigned v4u __attribute__((ext_vector_type(4)));
typedef float f32x4 __attribute__((ext_vector_type(4)));
typedef short bf16x8 __attribute__((ext_vector_type(8)));
typedef GAS unsigned gu32;
typedef GAS unsigned long long gu64;
#define RLX_AGENT __ATOMIC_RELAXED, __HIP_MEMORY_SCOPE_AGENT
#define LDS_WAIT() asm volatile("s_waitcnt lgkmcnt(0)" ::: "memory")
#define VM_WAIT() asm volatile("s_waitcnt vmcnt(0)" ::: "memory")
__device__ __forceinline__ unsigned long long rt() { return __builtin_amdgcn_s_memrealtime(); }
__device__ __forceinline__ unsigned f2bf(float f) { unsigned u = __builtin_bit_cast(unsigned, f); return (u + 0x7fffu + ((u >> 16) & 1u)) >> 16; }
__device__ __forceinline__ unsigned pk2(float lo, float hi) { return f2bf(lo) | (f2bf(hi) << 16); }
#define XB_TMO      128
#define XB_XCNT(j)  (256  + 64 * (j))
#define XB_XSUB(j)  (1280 + 64 * (j))
#define XB_XGEN(j)  (2304 + 64 * (j))
#define XB_TOP      3328
#define XB_TOPGEN   3392
#define XCD_BAR_WORDS 3456
#define XB_SPIN_CAP (1u << 18)

__device__ __forceinline__ unsigned xb_ld(unsigned* p)              { return __hip_atomic_load(p, __ATOMIC_RELAXED, __HIP_MEMORY_SCOPE_AGENT); }
__device__ __forceinline__ unsigned xb_add(unsigned* p, unsigned v) { return __hip_atomic_fetch_add(p, v, __ATOMIC_RELAXED, __HIP_MEMORY_SCOPE_AGENT); }
__device__ __forceinline__ unsigned xb_xcc_id() { return (unsigned)__builtin_amdgcn_s_getreg((3 << 11) | 20) & 0xFu; }
#define XB_SPIN(cond, bar) do { unsigned _sp = 0; while (cond) { __builtin_amdgcn_s_sleep(1); \
    if ((++_sp & 255u) == 0u) { if (xb_ld(&(bar)[XB_TMO])) break; if (_sp > XB_SPIN_CAP) { atomicAdd(&(bar)[XB_TMO], 1u); break; } } } } while (0)

struct XcdBarrier {
    unsigned* bar; unsigned x;
    volatile LAS unsigned* st;
};

__device__ __forceinline__ XcdBarrier xcd_barrier_post(unsigned* bar, volatile LAS unsigned* st) {
    XcdBarrier b; b.bar = bar; b.x = xb_xcc_id(); b.st = st;
    if (threadIdx.x == 0) (void)xb_add(&bar[XB_XCNT(b.x)], 1u);
    return b;
}
__device__ __forceinline__ void xcd_barrier_complete(unsigned* bar, unsigned x, unsigned& nloc, unsigned& nx) {
    const unsigned G = gridDim.x * gridDim.y * gridDim.z;
    unsigned sum, cnt, mine, sp = 0u;
    for (;;) {
        sum = 0u; cnt = 0u; mine = 0u;
#pragma unroll
        for (unsigned j = 0; j < 16; ++j) { const unsigned c = xb_ld(&bar[XB_XCNT(j)]); sum += c; cnt += (c > 0u) ? 1u : 0u; mine = (j == x) ? c : mine; }
        if (sum == G) break;
        __builtin_amdgcn_s_sleep(1);
        if ((++sp & 255u) == 0u) { if (xb_ld(&bar[XB_TMO])) break; if (sp > XB_SPIN_CAP) { atomicAdd(&bar[XB_TMO], 1u); break; } }
    }
    nloc = mine > 0u ? mine : 1u; nx = cnt > 0u ? cnt : 1u;
}

__device__ __forceinline__ void xcd_barrier(const XcdBarrier& b) {
    asm volatile("s_waitcnt vmcnt(0)" ::: "memory");
    __syncthreads();
    if (threadIdx.x == 0) {
        unsigned* bar = b.bar;
        __builtin_amdgcn_s_waitcnt(0);
        unsigned nloc = b.st[0], nx = b.st[1];
        if (nloc == 0u) { xcd_barrier_complete(bar, b.x, nloc, nx); b.st[0] = nloc; b.st[1] = nx; }
        const unsigned old = xb_add(&bar[XB_XSUB(b.x)], 1u);
        const unsigned gen = old / nloc;
        if (old + 1u == (gen + 1u) * nloc) {
            __builtin_amdgcn_fence(__ATOMIC_RELEASE, "agent");
            asm volatile("s_waitcnt vmcnt(0)" ::: "memory");
            const unsigned og = xb_add(&bar[XB_TOP], 1u);
            const unsigned tg = og / nx;
            if (og + 1u == (tg + 1u) * nx) xb_add(&bar[XB_TOPGEN], 1u);
            else XB_SPIN(xb_ld(&bar[XB_TOPGEN]) == tg, bar);
            __builtin_amdgcn_fence(__ATOMIC_ACQUIRE, "agent");
            xb_add(&bar[XB_XGEN(b.x)], 1u);
            asm volatile("s_waitcnt vmcnt(0)" ::: "memory");
        } else {
            XB_SPIN(xb_ld(&bar[XB_XGEN(b.x)]) == gen, bar);
            __builtin_amdgcn_fence(__ATOMIC_ACQUIRE, "agent");
            asm volatile("s_waitcnt vmcnt(0)" ::: "memory");
        }
    }
    __syncthreads();
}

typedef float f32x16 __attribute__((ext_vector_type(16)));
typedef short s16x4 __attribute__((ext_vector_type(4)));
typedef float f32x2_t __attribute__((ext_vector_type(2)));
typedef __bf16 bf16x2_t __attribute__((ext_vector_type(2)));
typedef LAS char lchar;
#define SBAR() __builtin_amdgcn_sched_barrier(0)
__device__ __forceinline__ float bf2f(unsigned short h) { return __uint_as_float((unsigned)h << 16); }
__device__ __forceinline__ float bflo(unsigned w) { return __uint_as_float(w << 16); }
__device__ __forceinline__ float bfhi(unsigned w) { return __uint_as_float(w & 0xffff0000u); }
__device__ __forceinline__ unsigned cvtpk(float lo, float hi) { f32x2_t v = {lo, hi}; bf16x2_t b = __builtin_convertvector(v, bf16x2_t); return __builtin_bit_cast(unsigned, b); }
__device__ __forceinline__ float wave_sum(float v) {
#pragma unroll
    for (int o = 1; o < 64; o <<= 1) v += __shfl_xor(v, o);
    return v;
}
__device__ __forceinline__ int crow(int r, int hi) { return (r & 3) + 8 * (r >> 2) + 4 * hi; }
__device__ __forceinline__ float pair_max(float a) { auto rr = __builtin_amdgcn_permlane32_swap(__float_as_uint(a), __float_as_uint(a), false, false); return fmaxf(__uint_as_float(rr[0]), __uint_as_float(rr[1])); }
__device__ __forceinline__ float pair_sum(float a) { auto rr = __builtin_amdgcn_permlane32_swap(__float_as_uint(a), __float_as_uint(a), false, false); return __uint_as_float(rr[0]) + __uint_as_float(rr[1]); }
__device__ __forceinline__ f32x16 mfma32(bf16x8 a, bf16x8 b, f32x16 c) { return __builtin_amdgcn_mfma_f32_32x32x16_bf16(a, b, c, 0, 0, 0); }

struct Frame {
    LAS unsigned char* lds;
    volatile LAS unsigned* MISC;
    gu32* ctl;
    int tid, lane, wave;
    int vcu, G;
};
struct Args { const void* in[26]; float* out; unsigned char* ws; int ph_lo, ph_hi; };
#define INF(i) ((const float*)A.in[i])
#define WSB(off) ((bf16*)(A.ws + (off)))

__device__ __forceinline__ void p0_transpose_item(const float* W, int K, int ldw, int nsrc, bf16* WT, int drow0, int scol0, int k0, LAS float* scr, int lane) {
    const int sc = scol0 + (lane & 31); const bool ok = sc < nsrc;
#pragma unroll 8
    for (int i = 0; i < 32; ++i) { const int kk = 2 * i + (lane >> 5); scr[kk * 33 + (lane & 31)] = ok ? W[(size_t)(k0 + kk) * ldw + sc] : 0.f; }
    LDS_WAIT(); asm volatile("" ::: "memory");
    const int c = lane & 7;
#pragma unroll
    for (int j = 0; j < 4; ++j) { const int n = (lane >> 3) + 8 * j; const LAS float* s = scr + (8 * c) * 33 + n;
        v4u o; o.x = pk2(s[0 * 33], s[1 * 33]); o.y = pk2(s[2 * 33], s[3 * 33]); o.z = pk2(s[4 * 33], s[5 * 33]); o.w = pk2(s[6 * 33], s[7 * 33]);
        *(GAS v4u*)(WT + (size_t)(drow0 + n) * K + k0 + 8 * c) = o; }
    LDS_WAIT(); asm volatile("" ::: "memory");
}
__device__ __forceinline__ void p0_plain(const float* W, int K, int nsrc, int ndest, bf16* WT, int item, LAS float* scr, int lane) {
    const int nblk = ndest / 32, kb = item / nblk, nb = item % nblk;
    p0_transpose_item(W, K, nsrc, nsrc, WT, 32 * nb, 32 * nb, 64 * kb, scr, lane);
}
__device__ __forceinline__ void rms_row_to_bf16(const float* xrow, const float* g, bf16* orow, int lane) {
    const GAS f32x4* xr = (const GAS f32x4*)xrow + lane; const GAS f32x4* gr = (const GAS f32x4*)g + lane;
    f32x4 v[4]; float s2 = 0.f;
#pragma unroll
    for (int j = 0; j < 4; ++j) { v[j] = xr[64 * j]; s2 += (v[j].x * v[j].x + v[j].y * v[j].y) + (v[j].z * v[j].z + v[j].w * v[j].w); }
    const float rstd = 1.0f / sqrtf(wave_sum(s2) * (1.f / DM) + EPS);
    GAS unsigned long long* o8 = (GAS unsigned long long*)orow + lane;
#pragma unroll
    for (int j = 0; j < 4; ++j) { const f32x4 gg = gr[64 * j]; const f32x4 y = v[j] * rstd * gg;
        o8[64 * j] = (unsigned long long)pk2(y.x, y.y) | ((unsigned long long)pk2(y.z, y.w) << 32); }
}
__device__ __forceinline__ void p0_prologue(Frame& F, const Args& A) {
    LAS float* scr = (LAS float*)(F.lds + RING_OFF + F.wave * 16384);
    const int gw = F.vcu * NWAVES + F.wave, NGW = F.G * NWAVES, lane = F.lane;
    constexpr int I_IN = 16 * (NPROJ / 32), I_W1 = 32 * 8, I_W2 = 4 * 2, I_SQ = 16 * 32, I_KV = 16 * 64, I_GU = 16 * (2 * DFF / 32), I_D = (DFF / 64) * 32;
    constexpr int NITEMS = I_IN + 2 * I_W1 + 2 * I_W2 + 3 * I_SQ + I_KV + I_GU + I_D;
    for (int it = gw; it < NITEMS; it += NGW) {
        int r = it;
        if (r < I_IN) { p0_plain(INF(4), DM, W_IN_COLS, NPROJ, WSB(WS_WIN), r, scr, lane); continue; } r -= I_IN;
        if (r < I_W1) { p0_plain(INF(7), 2048, 256, 256, WSB(WS_W1KC), r, scr, lane); continue; } r -= I_W1;
        if (r < I_W1) { p0_plain(INF(10), 2048, 256, 256, WSB(WS_W1VC), r, scr, lane); continue; } r -= I_W1;
        if (r < I_W2) { p0_plain(INF(8), 256, 64, 64, WSB(WS_W2KC), r, scr, lane); continue; } r -= I_W2;
        if (r < I_W2) { p0_plain(INF(11), 256, 64, 64, WSB(WS_W2VC), r, scr, lane); continue; } r -= I_W2;
        if (r < I_SQ) { p0_plain(INF(14), DM, DM, DM, WSB(WS_WOUT), r, scr, lane); continue; } r -= I_SQ;
        if (r < I_SQ) { p0_plain(INF(18), DM, DM, DM, WSB(WS_WQ), r, scr, lane); continue; } r -= I_SQ;
        if (r < I_SQ) { p0_plain(INF(20), DM, DM, DM, WSB(WS_WO), r, scr, lane); continue; } r -= I_SQ;
        if (r < I_KV) { p0_plain(INF(19), DM, 2 * DM, 2 * DM, WSB(WS_WKV), r, scr, lane); continue; } r -= I_KV;
        if (r < I_GU) {
            constexpr int nblk = 2 * DFF / 32; const int kb = r / nblk, nb = r % nblk, n0 = 32 * nb, pn = n0 >> 8, rl = n0 & 255;
            const int scol0 = rl < 128 ? 128 * pn + rl : DFF + 128 * pn + (rl - 128);
            p0_transpose_item(INF(23), DM, 2 * DFF, 2 * DFF, WSB(WS_WGU), n0, scol0, 64 * kb, scr, lane); continue; } r -= I_GU;
        p0_plain(INF(24), DFF, DM, DM, WSB(WS_WD), r, scr, lane);
    }
    for (int it = gw; it < 64; it += NGW) {
        const int mat = it >> 5, nc = (it >> 3) & 3, kc = it & 7; const float* w1 = mat ? INF(10) : INF(7); const float* pe = mat ? INF(9) : INF(6);
        float s = 0.f; const int n = 64 * nc + lane;
#pragma unroll 8
        for (int k = 256 * kc; k < 256 * kc + 256; ++k) s += pe[k] * w1[(size_t)k * 256 + n];
        atomicAdd((mat ? ((float*)(A.ws + WS_BIAS) + 256) : ((float*)(A.ws + WS_BIAS))) + n, s);
    }
    for (int m = gw; m < MTOK; m += NGW) rms_row_to_bf16(INF(0) + (size_t)m * DM, INF(3), WSB(WS_XN) + (size_t)m * DM, lane);
    for (int m = gw; m < MMEM; m += NGW) rms_row_to_bf16(INF(1) + (size_t)m * DM, INF(17), WSB(WS_MN) + (size_t)m * DM, lane);
}

__device__ __forceinline__ void p2_rope(Frame& F, const Args& A) {
    const int gw = F.vcu * NWAVES + F.wave, NGW = F.G * NWAVES, lane = F.lane, f = lane & 31, sh = lane >> 5;
    const float inv = powf(10000.0f, -(float)f / 32.0f);
    for (int tok = gw; tok < MTOK; tok += NGW) {
        const float ang = (float)((const int*)A.in[2])[tok] * inv; float sn, cs; sincosf(ang, &sn, &cs);
        bf16* row = WSB(WS_PROJ) + (size_t)tok * NPROJ;
#pragma unroll
        for (int i = 0; i < 6; ++i) { const int slot = sh * 6 + i;
            const int c0 = slot < 8 ? COL_Q + 64 * slot : (slot < 10 ? COL_KSL + 64 * (slot - 8) : COL_KW + 64 * (slot - 10));
            const float sc = slot < 8 ? C2_NSA : 1.0f;
            const float x1 = bf2f(row[c0 + f]), x2 = bf2f(row[c0 + f + 32]);
            row[c0 + f] = (bf16)f2bf((x1 * cs - x2 * sn) * sc); row[c0 + f + 32] = (bf16)f2bf((x2 * cs + x1 * sn) * sc); }
    }
}
constexpr int HS_PITCH = 264;
__device__ __forceinline__ void compress_unit(Frame& F, const Args& A, int u) {
    const int kv = u & 1, slab = (u >> 1) & 7, bgi = u >> 4, b = bgi >> 1, g = bgi & 1;
    const int lane = F.lane, w = F.wave, r32 = lane & 31, hi = lane >> 5;
    const bf16* W1t = kv ? WSB(WS_W1VC) : WSB(WS_W1KC); const bf16* W2t = kv ? WSB(WS_W2VC) : WSB(WS_W2KC); const float* bias1 = kv ? ((float*)(A.ws + WS_BIAS) + 256) : ((float*)(A.ws + WS_BIAS));
    const bf16* src = WSB(WS_PROJ) + (size_t)(b * SEQ + 16 * (32 * slab + r32)) * NPROJ + (kv ? COL_VC : COL_KC) + g * 64 + 8 * hi;
    const bf16* wsrc = W1t + (size_t)(32 * w + r32) * 2048 + 8 * hi;
    f32x16 acc = {};
#pragma unroll 2
    for (int l = 0; l < 32; ++l) {
#pragma unroll
        for (int d0 = 0; d0 < 4; ++d0) {
            const bf16x8 a = *(const GAS bf16x8*)(src + (size_t)l * NPROJ + 16 * d0);
            const bf16x8 bb = *(const GAS bf16x8*)(wsrc + 64 * l + 16 * d0);
            acc = mfma32(a, bb, acc);
        }
    }
    LAS bf16* Hs = (LAS bf16*)(F.lds + RING_OFF);
    { const float bv = bias1[32 * w + r32];
#pragma unroll
      for (int r = 0; r < 16; ++r) { const float h = pg8::silu_f(acc[r] + bv); Hs[crow(r, hi) * HS_PITCH + 32 * w + r32] = (bf16)f2bf(h); } }
    __syncthreads();
    if (w == 0) {
        f32x16 a2[2]; a2[0] = (f32x16){}; a2[1] = (f32x16){};
#pragma unroll
        for (int ks = 0; ks < 16; ++ks) {
            const bf16x8 a = *(const LAS bf16x8*)(Hs + r32 * HS_PITCH + 16 * ks + 8 * hi);
#pragma unroll
            for (int cb = 0; cb < 2; ++cb) { const bf16x8 bb = *(const GAS bf16x8*)(W2t + (size_t)(32 * cb + r32) * 256 + 16 * ks + 8 * hi); a2[cb] = mfma32(a, bb, a2[cb]); }
        }
        bf16* dst = (kv ? WSB(WS_VCMP) : WSB(WS_KCMP)) + (size_t)bgi * 256 * 64;
        const float inv = powf(10000.0f, -(float)r32 / 32.0f);
#pragma unroll
        for (int r = 0; r < 16; ++r) {
            const int i = 32 * slab + crow(r, hi); float o1 = a2[0][r], o2 = a2[1][r];
            if (kv == 0) { int tp = 16 * i + 31; tp = tp > SEQ - 1 ? SEQ - 1 : tp; const float ang = (float)((const int*)A.in[2])[b * SEQ + tp] * inv; float sn, cs; sincosf(ang, &sn, &cs);
                const float x1 = o1, x2 = o2; o1 = x1 * cs - x2 * sn; o2 = x2 * cs + x1 * sn; }
            if (i >= 255) { o1 = 0.f; o2 = 0.f; }
            dst[(size_t)i * 64 + r32] = (bf16)f2bf(o1); dst[(size_t)i * 64 + 32 + r32] = (bf16)f2bf(o2);
        }
    }
    __syncthreads();
}

template <int ND0>
__device__ __forceinline__ void qkt(f32x16& p0, f32x16& p1, const lchar* kslot, const bf16x8* qr, int r32, int hi) {
    const lchar* kb = kslot + hi * 1024 + r32 * 16;
    p0 = (f32x16){}; p1 = (f32x16){};
#pragma unroll
    for (int d0 = 0; d0 < ND0; ++d0) {
        const bf16x8 b0 = *(const LAS bf16x8*)(kb + d0 * 2048), b1 = *(const LAS bf16x8*)(kb + d0 * 2048 + 512);
        p0 = mfma32(b0, qr[d0], p0); p1 = mfma32(b1, qr[d0], p1);
    }
}
template <int NDB>
__device__ __forceinline__ void pv(f32x16* o, unsigned vb, bf16x8 pa0, bf16x8 pa1, bf16x8 pa2, bf16x8 pa3) {
#pragma unroll
    for (int d0 = 0; d0 < NDB; ++d0) { s16x4 lo[4], hi[4];
#pragma unroll
        for (int ks = 0; ks < 4; ++ks) {
            asm volatile("ds_read_b64_tr_b16 %0,%1 offset:%c2" : "=&v"(lo[ks]) : "v"(vb), "i"(d0 * 4096 + ks * 1024) : "memory");
            asm volatile("ds_read_b64_tr_b16 %0,%1 offset:%c2" : "=&v"(hi[ks]) : "v"(vb), "i"(d0 * 4096 + ks * 1024 + 512) : "memory"); }
        asm volatile("s_waitcnt lgkmcnt(0)" ::: "memory"); SBAR();
#define PKV(k) (bf16x8){lo[k][0], lo[k][1], lo[k][2], lo[k][3], hi[k][0], hi[k][1], hi[k][2], hi[k][3]}
        o[d0] = mfma32(pa0, PKV(0), o[d0]);
        o[d0] = mfma32(pa1, PKV(1), o[d0]);
        o[d0] = mfma32(pa2, PKV(2), o[d0]);
        o[d0] = mfma32(pa3, PKV(3), o[d0]);
#undef PKV
    }
}
__device__ __forceinline__ float rowmax32(const f32x16& p0, const f32x16& p1) {
    float a = fmaxf(p0[0], p1[0]);
#pragma unroll
    for (int r = 1; r < 16; ++r) a = fmaxf(a, fmaxf(p0[r], p1[r]));
    return pair_max(a);
}
__device__ __forceinline__ void mask_range(f32x16& p0, f32x16& p1, int lo, int hi_, int hi) {
#pragma unroll
    for (int r = 0; r < 16; ++r) { const int kv = crow(r, hi);
        if (kv < lo || kv > hi_) p0[r] = -INFINITY;
        if (kv + 32 < lo || kv + 32 > hi_) p1[r] = -INFINITY; }
}
#define PKW(P, B) cvtpk(P[B], P[B + 1])
#define PACK4(P, B) __builtin_bit_cast(bf16x8, (v4u){PKW(P, B), PKW(P, B + 2), PKW(P, B + 4), PKW(P, B + 6)})

struct TileSrc { const bf16* K; const bf16* V; int pitch; };
__device__ __forceinline__ void tile_load(v4u& kr, v4u& vr, const TileSrc& s, int key0, int lane, int w) {
    kr = *(const GAS v4u*)(s.K + (size_t)(key0 + lane) * s.pitch + w * 8);
    vr = *(const GAS v4u*)(s.V + (size_t)(key0 + 16 * (w & 3) + (lane >> 2)) * s.pitch + (w >> 2) * 32 + (lane & 3) * 8);
}
__device__ __forceinline__ void tile_store(lchar* kslot, lchar* vslot, const v4u& kr, const v4u& vr, int lane, int w) {
    *(LAS v4u*)(kslot + w * 1024 + lane * 16) = kr; *(LAS v4u*)(vslot + w * 1024 + lane * 16) = vr;
}

struct Br { f32x16 o[2]; float m, l; };
__device__ __forceinline__ void flash_tile(Br& st, const lchar* kslot, unsigned vb, const bf16x8* qr, bool need_mask, int mlo, int mhi, LAS float* wsf, int r32, int hi) {
    f32x16 p0, p1; qkt<4>(p0, p1, kslot, qr, r32, hi);
    if (need_mask) mask_range(p0, p1, mlo, mhi, hi);
    const float rm = rowmax32(p0, p1);
    if (__any(rm > st.m)) {
        const float mn = fmaxf(st.m, rm); const float al = (mn == -INFINITY) ? 1.0f : __builtin_amdgcn_exp2f(st.m - mn);
        st.l *= al; st.m = mn;
        if (hi == 0) wsf[r32] = al;
        LDS_WAIT(); asm volatile("" ::: "memory");
#pragma unroll
        for (int r = 0; r < 16; ++r) { const float a = wsf[crow(r, hi)]; st.o[0][r] *= a; st.o[1][r] *= a; }
    }
    const float ms = (st.m == -INFINITY) ? 0.f : st.m;
    float s = 0.f;
#pragma unroll
    for (int r = 0; r < 16; ++r) { p0[r] = __builtin_amdgcn_exp2f(p0[r] - ms); p1[r] = __builtin_amdgcn_exp2f(p1[r] - ms); s += p0[r] + p1[r]; }
    st.l += s;
    pv<2>(st.o, vb, PACK4(p0, 0), PACK4(p0, 8), PACK4(p1, 0), PACK4(p1, 8));
}

__device__ __forceinline__ void nsa_unit(Frame& F, const Args& A, int b, int qt) {
    const int lane = F.lane, w = F.wave, tid = F.tid, r32 = lane & 31, hi = lane >> 5;
    lchar* ring = (lchar*)(F.lds + RING_OFF);
    LAS float* wsf = (LAS float*)(F.lds + WSF_OFF) + w * 64;
    LAS float* IMP = (LAS float*)(ring + NS_IMP);
    LAS unsigned long long* SELM = (LAS unsigned long long*)(ring + NS_SELM);
    LAS bf16* YST = (LAS bf16*)(ring + NS_YST);
    const unsigned vlane = (unsigned)(((lane >> 4) & 1) * 32 + (lane & 3) * 8 + (4 * hi + ((lane & 15) >> 2)) * 64);
    const unsigned ring_addr = (unsigned)(uintptr_t)ring;
    const int qi = r32 & 7, hd = r32 >> 3, tl = 8 * w + qi;
    const size_t tok0 = (size_t)b * SEQ;
    const size_t mytok = tok0 + 64 * qt + tl;

#pragma nounroll
    for (int g = 0; g < 2; ++g) {
        bf16x8 qr[4];
        { const bf16* qp = WSB(WS_PROJ) + mytok * NPROJ + COL_Q + (g * 4 + hd) * 64 + 8 * hi;
#pragma unroll
          for (int d0 = 0; d0 < 4; ++d0) qr[d0] = *(const GAS bf16x8*)(qp + 16 * d0); }
        float gate[3];
        { const bf16* gp = WSB(WS_PROJ) + mytok * NPROJ + COL_GL + (g * 4 + hd) * 3;
#pragma unroll
          for (int k = 0; k < 3; ++k) gate[k] = __builtin_amdgcn_rcpf(1.0f + __builtin_amdgcn_exp2f(-LOG2E * bf2f(gp[k]))); }
        f32x16 y[2]; y[0] = (f32x16){}; y[1] = (f32x16){};
#pragma unroll
        for (int i = 0; i < 8; ++i) IMP[tid + 512 * i] = 0.f;

        const int imax = (64 * qt + tl - 31) >> 4;
        const int ntc = ((4 * qt + 2) >> 6) + 1;
        TileSrc sc; sc.K = WSB(WS_KCMP) + (size_t)(b * 2 + g) * 256 * 64; sc.V = WSB(WS_VCMP) + (size_t)(b * 2 + g) * 256 * 64; sc.pitch = 64;
        float cm = -INFINITY, cl = 0.f;
        v4u kr, vr;
#ifndef X_NOCMP
        {
            tile_load(kr, vr, sc, 0, lane, w); tile_store(ring + NS_K, ring + NS_V, kr, vr, lane, w); __syncthreads();
#pragma nounroll
            for (int it = 0; it < ntc; ++it) {
                const int cur = it & 1;
                if (it + 1 < ntc) tile_load(kr, vr, sc, 64 * (it + 1), lane, w);
                f32x16 p0, p1; qkt<4>(p0, p1, ring + NS_K + cur * 8192, qr, r32, hi);
                mask_range(p0, p1, 0, imax - 64 * it, hi);
                const float rm = rowmax32(p0, p1); const float mn = fmaxf(cm, rm);
                const float al = (mn == -INFINITY) ? 1.0f : __builtin_amdgcn_exp2f(cm - mn); cl *= al; cm = mn;
                const float ms = (mn == -INFINITY) ? 0.f : mn; float sm = 0.f;
#pragma unroll
                for (int r = 0; r < 16; ++r) sm += __builtin_amdgcn_exp2f(p0[r] - ms) + __builtin_amdgcn_exp2f(p1[r] - ms);
                cl += sm;
                if (it + 1 < ntc) tile_store(ring + NS_K + (cur ^ 1) * 8192, ring + NS_V + (cur ^ 1) * 8192, kr, vr, lane, w);
                __syncthreads();
            }
            cl = pair_sum(cl);
        }
        {
            const float inv_l = cl > 0.f ? 1.0f / cl : 0.f, ms = (cm == -INFINITY) ? 0.f : cm, g0 = gate[0];
            tile_load(kr, vr, sc, 0, lane, w); tile_store(ring + NS_K, ring + NS_V, kr, vr, lane, w); __syncthreads();
#pragma nounroll
            for (int it = 0; it < ntc; ++it) {
                const int cur = it & 1;
                if (it + 1 < ntc) tile_load(kr, vr, sc, 64 * (it + 1), lane, w);
                const unsigned vb = ring_addr + NS_V + cur * 8192 + vlane;
                f32x16 p0, p1; qkt<4>(p0, p1, ring + NS_K + cur * 8192, qr, r32, hi);
                mask_range(p0, p1, 0, imax - 64 * it, hi);
#pragma unroll
                for (int r = 0; r < 16; ++r) { p0[r] = __builtin_amdgcn_exp2f(p0[r] - ms) * inv_l; p1[r] = __builtin_amdgcn_exp2f(p1[r] - ms) * inv_l; }
                LAS float* imq = IMP + tl * 64 + 16 * it + hi;
#pragma unroll
                for (int rq = 0; rq < 4; ++rq) {
                    const float c0 = 0.5f * p0[4 * rq + 3], a0 = (p0[4 * rq] + p0[4 * rq + 1]) + (p0[4 * rq + 2] + c0);
                    const float c1 = 0.5f * p1[4 * rq + 3], a1 = (p1[4 * rq] + p1[4 * rq + 1]) + (p1[4 * rq + 2] + c1);
                    const int j0 = 2 * rq, j1 = 8 + 2 * rq;
                    __hip_atomic_fetch_add(imq + j0, a0, __ATOMIC_RELAXED, __HIP_MEMORY_SCOPE_WORKGROUP);
                    __hip_atomic_fetch_add(imq + j0 + 1, c0, __ATOMIC_RELAXED, __HIP_MEMORY_SCOPE_WORKGROUP);
                    __hip_atomic_fetch_add(imq + j1, a1, __ATOMIC_RELAXED, __HIP_MEMORY_SCOPE_WORKGROUP);
                    if (16 * it + hi + j1 + 1 < 64) __hip_atomic_fetch_add(imq + j1 + 1, c1, __ATOMIC_RELAXED, __HIP_MEMORY_SCOPE_WORKGROUP);
                }
#pragma unroll
                for (int r = 0; r < 16; ++r) { p0[r] *= g0; p1[r] *= g0; }
                pv<2>(y, vb, PACK4(p0, 0), PACK4(p0, 8), PACK4(p1, 0), PACK4(p1, 8));
                if (it + 1 < ntc) tile_store(ring + NS_K + (cur ^ 1) * 8192, ring + NS_V + (cur ^ 1) * 8192, kr, vr, lane, w);
                __syncthreads();
            }
        }
#endif
        __syncthreads();
        {
            const bool forced = (lane == 0) || (lane == qt) || (lane == qt - 1); const bool future = lane > qt;
#pragma nounroll
            for (int k8 = 0; k8 < 8; ++k8) {
                const float v = IMP[(8 * w + k8) * 64 + lane];
                const float val = forced ? 1e4f : (future ? -1e4f : v);
                int rank = 0;
                wsf[lane] = val; LDS_WAIT(); asm volatile("" ::: "memory");
#pragma unroll 8
                for (int k = 0; k < 64; ++k) { const float vk = wsf[k]; rank += (vk > val || (vk == val && k < lane)) ? 1 : 0; }
                asm volatile("" ::: "memory");
                const unsigned long long mk = __ballot(rank < 16);
                if (lane == 0) SELM[8 * w + k8] = mk;
            }
        }
        __syncthreads();
        const unsigned long long mysel = SELM[tl];
        unsigned long long umask = 0ull;
#pragma unroll
        for (int k8 = 0; k8 < 8; ++k8) umask |= SELM[8 * w + k8];
        const unsigned um_lo = __builtin_amdgcn_readfirstlane((unsigned)umask), um_hi = __builtin_amdgcn_readfirstlane((unsigned)(umask >> 32));

#ifndef X_NOBR
#pragma nounroll
        for (int br = 1; br < 3; ++br) {
            TileSrc ss; ss.pitch = NPROJ;
            ss.K = WSB(WS_PROJ) + tok0 * NPROJ + (br == 1 ? COL_KSL : COL_KW) + g * 64; ss.V = WSB(WS_PROJ) + tok0 * NPROJ + (br == 1 ? COL_VSL : COL_VW) + g * 64;
            const int t_lo = (br == 1) ? 0 : (qt >= 8 ? qt - 8 : 0), nT = qt - t_lo + 1;
            Br st; st.o[0] = (f32x16){}; st.o[1] = (f32x16){}; st.m = -INFINITY; st.l = 0.f;
            tile_load(kr, vr, ss, 64 * t_lo, lane, w); tile_store(ring + NS_K, ring + NS_V, kr, vr, lane, w); __syncthreads();
#pragma nounroll
            for (int it = 0; it < nT; ++it) {
                const int T = t_lo + it, cur = it & 1;
                if (it + 1 < nT) tile_load(kr, vr, ss, 64 * (T + 1), lane, w);
                const lchar* kslot = ring + NS_K + cur * 8192; const unsigned vb = ring_addr + NS_V + cur * 8192 + vlane;
                bool active = true, need_mask; int mlo = 0, mhi = 63;
                if (br == 1) {
                    const bool selbit = (mysel >> T) & 1ull; active = ((T < 32 ? (um_lo >> T) : (um_hi >> (T - 32))) & 1u) != 0u;
                    mlo = selbit ? 0 : 64; if (T == qt) mhi = tl; need_mask = (T == qt) || !__all(selbit);
                } else {
                    if (T == qt) mhi = tl;
                    if (T == qt - 8) mlo = tl + 1;
                    need_mask = (T == qt) || (T == qt - 8);
                }
                if (active) flash_tile(st, kslot, vb, qr, need_mask, mlo, mhi, wsf, r32, hi);
                if (it + 1 < nT) tile_store(ring + NS_K + (cur ^ 1) * 8192, ring + NS_V + (cur ^ 1) * 8192, kr, vr, lane, w);
                __syncthreads();
            }
            const float lt = pair_sum(st.l); const float gbr = (br == 1) ? gate[1] : gate[2]; const float fsc = lt > 0.f ? gbr / lt : 0.f;
            if (hi == 0) wsf[r32] = fsc;
            LDS_WAIT(); asm volatile("" ::: "memory");
#pragma unroll
            for (int r = 0; r < 16; ++r) { const float a = wsf[crow(r, hi)]; y[0][r] += a * st.o[0][r]; y[1][r] += a * st.o[1][r]; }
        }
#endif
#pragma unroll
        for (int r = 0; r < 16; ++r) { const int row = crow(r, hi), q = 8 * w + (row & 7), ch = (g * 4 + (row >> 3)) * 64 + r32;
            YST[q * 512 + ch] = (bf16)f2bf(y[0][r]); YST[q * 512 + ch + 32] = (bf16)f2bf(y[1][r]); }
    }
    __syncthreads();
#pragma nounroll
    for (int k8 = 0; k8 < 8; ++k8) {
        const int q = 8 * w + k8, s = 64 * qt + q; const size_t tok = tok0 + s;
        { const v4u yv = *(const LAS v4u*)(YST + q * 512 + 8 * lane);
          float v[8] = {bflo(yv.x), bfhi(yv.x), bflo(yv.y), bfhi(yv.y), bflo(yv.z), bfhi(yv.z), bflo(yv.w), bfhi(yv.w)}; float s2 = 0.f;
#pragma unroll
          for (int e = 0; e < 8; ++e) s2 += v[e] * v[e];
          const float rstd = 1.0f / sqrtf(wave_sum(s2) * (1.f / 512.f) + EPS);
          const f32x4 g0 = *(const GAS f32x4*)(INF(13) + 8 * lane), g1 = *(const GAS f32x4*)(INF(13) + 8 * lane + 4);
          v4u o; o.x = pk2(v[0] * rstd * g0.x, v[1] * rstd * g0.y); o.y = pk2(v[2] * rstd * g0.z, v[3] * rstd * g0.w); o.z = pk2(v[4] * rstd * g1.x, v[5] * rstd * g1.y); o.w = pk2(v[6] * rstd * g1.z, v[7] * rstd * g1.w);
          *(GAS v4u*)(WSB(WS_MIXED) + tok * DM + 512 + 8 * lane) = o; }
        { const bf16* rowp = WSB(WS_PROJ) + tok * NPROJ + 8 * lane;
          const v4u bgv = *(const GAS v4u*)(rowp + COL_BG);
          float zc[8] = {0.f, 0.f, 0.f, 0.f, 0.f, 0.f, 0.f, 0.f};
#pragma unroll
          for (int k = 0; k < 3; ++k) {
              const int back = 2 - k;
              if (s - back >= 0) {
                  const bf16* rp = rowp - (size_t)back * NPROJ;
                  const v4u cgv = *(const GAS v4u*)(rp + COL_CG), xiv = *(const GAS v4u*)(rp + COL_XIN);
                  const f32x4 w0 = *(const GAS f32x4*)(INF(5) + k * 512 + 8 * lane), w1 = *(const GAS f32x4*)(INF(5) + k * 512 + 8 * lane + 4);
                  zc[0] += w0.x * bflo(cgv.x) * bflo(xiv.x); zc[1] += w0.y * bfhi(cgv.x) * bfhi(xiv.x); zc[2] += w0.z * bflo(cgv.y) * bflo(xiv.y); zc[3] += w0.w * bfhi(cgv.y) * bfhi(xiv.y);
                  zc[4] += w1.x * bflo(cgv.z) * bflo(xiv.z); zc[5] += w1.y * bfhi(cgv.z) * bfhi(xiv.z); zc[6] += w1.z * bflo(cgv.w) * bflo(xiv.w); zc[7] += w1.w * bfhi(cgv.w) * bfhi(xiv.w);
              }
          }
          float v[8] = {bflo(bgv.x) * zc[0], bfhi(bgv.x) * zc[1], bflo(bgv.y) * zc[2], bfhi(bgv.y) * zc[3], bflo(bgv.z) * zc[4], bfhi(bgv.z) * zc[5], bflo(bgv.w) * zc[6], bfhi(bgv.w) * zc[7]}; float s2 = 0.f;
#pragma unroll
          for (int e = 0; e < 8; ++e) s2 += v[e] * v[e];
          const float rstd = 1.0f / sqrtf(wave_sum(s2) * (1.f / 512.f) + EPS);
          const f32x4 g0 = *(const GAS f32x4*)(INF(12) + 8 * lane), g1 = *(const GAS f32x4*)(INF(12) + 8 * lane + 4);
          v4u o; o.x = pk2(v[0] * rstd * g0.x, v[1] * rstd * g0.y); o.y = pk2(v[2] * rstd * g0.z, v[3] * rstd * g0.w); o.z = pk2(v[4] * rstd * g1.x, v[5] * rstd * g1.y); o.w = pk2(v[6] * rstd * g1.z, v[7] * rstd * g1.w);
          *(GAS v4u*)(WSB(WS_MIXED) + tok * DM + 8 * lane) = o; }
    }
    __syncthreads();
}

__device__ __forceinline__ void xattn_unit(Frame& F, const Args& A, int b, int h, int qb) {
    const int lane = F.lane, w = F.wave, r32 = lane & 31, hi = lane >> 5;
    lchar* ring = (lchar*)(F.lds + RING_OFF);
    LAS float* wsf = (LAS float*)(F.lds + WSF_OFF) + w * 64;
    const unsigned vlane = (unsigned)(((lane >> 4) & 1) * 32 + (lane & 3) * 8 + (4 * hi + ((lane & 15) >> 2)) * 64);
    const unsigned ring_addr = (unsigned)(uintptr_t)ring;
    const size_t qrow0 = (size_t)b * SEQ + 256 * qb + 32 * w;
    const bf16* Kx = WSB(WS_KVX) + (size_t)(b * MEM_LEN) * 2048 + h * 256;
    const bf16* Vx = Kx + 1024;
    const bf16* qp = WSB(WS_QX) + (qrow0 + r32) * DM + h * 256 + 8 * hi;
    v4u st2[2];
#define XK_LOAD(T, dh) do { _Pragma("unroll") for (int i = 0; i < 2; ++i) st2[i] = *(const GAS v4u*)(Kx + (size_t)(64 * (T) + lane) * 2048 + (dh) * 128 + (w + 8 * i) * 8); } while (0)
#define XV_LOAD(T, dh) do { _Pragma("unroll") for (int i = 0; i < 2; ++i) { const int p = w + 8 * i; st2[i] = *(const GAS v4u*)(Vx + (size_t)(64 * (T) + 16 * (p & 3) + (lane >> 2)) * 2048 + (dh) * 128 + 32 * (p >> 2) + 8 * (lane & 3)); } } while (0)
#define X_STORE(buf) do { _Pragma("unroll") for (int i = 0; i < 2; ++i) *(LAS v4u*)(ring + (buf) * 16384 + (w + 8 * i) * 1024 + lane * 16) = st2[i]; } while (0)
    f32x16 s[4][2];
#pragma unroll
    for (int T = 0; T < 4; ++T) { s[T][0] = (f32x16){}; s[T][1] = (f32x16){}; }
    XK_LOAD(0, 0); X_STORE(0); __syncthreads();
    bf16x8 qr[8];
#pragma unroll
    for (int it = 0; it < 8; ++it) {
        const int dh = it >> 2, T = it & 3;
        if (T == 0) {
#pragma unroll
            for (int d0 = 0; d0 < 8; ++d0) qr[d0] = *(const GAS bf16x8*)(qp + dh * 128 + 16 * d0);
        }
        if (it < 7) XK_LOAD((it + 1) & 3, (it + 1) >> 2);
        { const lchar* kb = ring + (it & 1) * 16384 + hi * 1024 + r32 * 16;
#pragma unroll
          for (int d0 = 0; d0 < 8; ++d0) { const bf16x8 b0 = *(const LAS bf16x8*)(kb + d0 * 2048), b1 = *(const LAS bf16x8*)(kb + d0 * 2048 + 512);
              s[T][0] = mfma32(b0, qr[d0], s[T][0]); s[T][1] = mfma32(b1, qr[d0], s[T][1]); } }
        if (it < 7) X_STORE((it + 1) & 1);
        __syncthreads();
    }
    XV_LOAD(0, 0);
    float m = rowmax32(s[0][0], s[0][1]);
#pragma unroll
    for (int T = 1; T < 4; ++T) m = fmaxf(m, rowmax32(s[T][0], s[T][1]));
    float l = 0.f; v4u pw[4][4];
#pragma unroll
    for (int T = 0; T < 4; ++T) {
#pragma unroll
        for (int r = 0; r < 16; ++r) { s[T][0][r] = __builtin_amdgcn_exp2f(s[T][0][r] - m); s[T][1][r] = __builtin_amdgcn_exp2f(s[T][1][r] - m); l += s[T][0][r] + s[T][1][r]; }
        pw[T][0] = (v4u){PKW(s[T][0], 0), PKW(s[T][0], 2), PKW(s[T][0], 4), PKW(s[T][0], 6)}; pw[T][1] = (v4u){PKW(s[T][0], 8), PKW(s[T][0], 10), PKW(s[T][0], 12), PKW(s[T][0], 14)};
        pw[T][2] = (v4u){PKW(s[T][1], 0), PKW(s[T][1], 2), PKW(s[T][1], 4), PKW(s[T][1], 6)}; pw[T][3] = (v4u){PKW(s[T][1], 8), PKW(s[T][1], 10), PKW(s[T][1], 12), PKW(s[T][1], 14)};
    }
    l = pair_sum(l);
    if (hi == 0) wsf[r32] = 1.0f / l;
    X_STORE(0); __syncthreads();
    LAS bf16* stg = (LAS bf16*)(ring + 32768 + w * 8192);
    bf16* Ow = WSB(WS_OX) + qrow0 * DM + h * 256;
#pragma unroll
    for (int dh = 0; dh < 2; ++dh) {
        f32x16 o[4];
#pragma unroll
        for (int d0 = 0; d0 < 4; ++d0) o[d0] = (f32x16){};
#pragma unroll
        for (int T = 0; T < 4; ++T) {
            const int it = dh * 4 + T;
            if (it < 7) XV_LOAD((it + 1) & 3, (it + 1) >> 2);
            pv<4>(o, ring_addr + (it & 1) * 16384 + vlane, __builtin_bit_cast(bf16x8, pw[T][0]), __builtin_bit_cast(bf16x8, pw[T][1]), __builtin_bit_cast(bf16x8, pw[T][2]), __builtin_bit_cast(bf16x8, pw[T][3]));
            if (it < 7) X_STORE((it + 1) & 1);
            __syncthreads();
        }
#pragma unroll
        for (int r = 0; r < 16; ++r) { const int row = crow(r, hi); const float a = wsf[row];
#pragma unroll
            for (int d0 = 0; d0 < 4; ++d0) stg[row * 128 + 32 * d0 + r32] = (bf16)f2bf(o[d0][r] * a); }
        LDS_WAIT(); asm volatile("" ::: "memory");
#pragma unroll
        for (int i = 0; i < 8; ++i) { const int row = 4 * i + (lane >> 4), ch = lane & 15; const v4u v = *(const LAS v4u*)(stg + row * 128 + ch * 8); *(GAS v4u*)(Ow + (size_t)row * DM + dh * 128 + ch * 8) = v; }
        LDS_WAIT(); asm volatile("" ::: "memory");
    }
#undef XK_LOAD
#undef XV_LOAD
#undef X_STORE
    __syncthreads();
}

__device__ __forceinline__ void resnorm_rows(Frame& F, const bf16* Zb, const float* base, const float* g1, float* out, const float* g2, bf16* xn) {
    const int gw = F.vcu * NWAVES + F.wave, NGW = F.G * NWAVES, lane = F.lane;
    for (int m = gw; m < MTOK; m += NGW) {
        const GAS unsigned long long* zr = (const GAS unsigned long long*)(Zb + (size_t)m * DM) + lane;
        const GAS f32x4* br = (const GAS f32x4*)(base + (size_t)m * DM) + lane;
        f32x4 z[4], hb[4]; float s2 = 0.f;
#pragma unroll
        for (int j = 0; j < 4; ++j) { const unsigned long long q = zr[64 * j]; const unsigned lo = (unsigned)q, hi = (unsigned)(q >> 32);
            z[j] = (f32x4){bflo(lo), bfhi(lo), bflo(hi), bfhi(hi)}; hb[j] = br[64 * j];
            s2 += (z[j].x * z[j].x + z[j].y * z[j].y) + (z[j].z * z[j].z + z[j].w * z[j].w); }
        const float rstd = 1.0f / sqrtf(wave_sum(s2) * (1.f / DM) + EPS);
        float h2 = 0.f;
#pragma unroll
        for (int j = 0; j < 4; ++j) { const f32x4 gg = ((const GAS f32x4*)g1 + lane)[64 * j]; hb[j] = hb[j] + z[j] * rstd * gg;
            h2 += (hb[j].x * hb[j].x + hb[j].y * hb[j].y) + (hb[j].z * hb[j].z + hb[j].w * hb[j].w);
            ((GAS f32x4*)(out + (size_t)m * DM) + lane)[64 * j] = hb[j]; }
        if (xn) {
            const float rs2 = 1.0f / sqrtf(wave_sum(h2) * (1.f / DM) + EPS);
            GAS unsigned long long* o8 = (GAS unsigned long long*)(xn + (size_t)m * DM) + lane;
#pragma unroll
            for (int j = 0; j < 4; ++j) { const f32x4 gg = ((const GAS f32x4*)g2 + lane)[64 * j]; const f32x4 y = hb[j] * rs2 * gg;
                o8[64 * j] = (unsigned long long)pk2(y.x, y.y) | ((unsigned long long)pk2(y.z, y.w) << 32); }
        }
    }
}

constexpr int N_PHASES = 13;
__global__ void __launch_bounds__(NWAVES * 64, 2) hymba_fwd(Args args) {
    const Args& A = args;
    extern __shared__ __attribute__((aligned(16))) unsigned char lds[];
    Frame F;
    F.lds = (LAS unsigned char*)lds;
    F.MISC = (volatile LAS unsigned*)(F.lds + MISC_OFF);
    F.tid = threadIdx.x; F.lane = F.tid & 63; F.wave = __builtin_amdgcn_readfirstlane(F.tid >> 6);
    F.G = gridDim.x; { const int bx = blockIdx.x; F.vcu = (F.G % 8 == 0) ? (bx % 8) * (F.G / 8) + bx / 8 : bx; }
    unsigned char* ws = args.ws;
    F.ctl = (gu32*)(ws + WS_CTL);
    for (int u = F.tid; u < (LDS_BYTES - LDSCTL_OFF) / 4; u += NWAVES * 64) ((LAS unsigned*)(F.lds + LDSCTL_OFF))[u] = 0u;
    __syncthreads();
    const bool one_launch = (args.ph_lo == 0 && args.ph_hi == N_PHASES);
    XcdBarrier bar; bar.bar = (unsigned*)(F.ctl + CW_BAR); bar.x = 0; bar.st = nullptr;
    if (one_launch) bar = xcd_barrier_post((unsigned*)(F.ctl + CW_BAR), F.MISC + 8);
    const int lo = args.ph_lo, hi = args.ph_hi;
#ifndef ONLY
#define ONLY -1
#endif
#define IN(k) ((ONLY < 0 || ONLY == (k)) && lo <= (k) && (k) < hi)
#define SEAM(k) do { if (IN(k) && IN((k) + 1)) xcd_barrier(bar); } while (0)

    if (IN(0)) { p0_prologue(F, A); } SEAM(0);
    if (IN(1)) {
        pg8::Gemm g{WSB(WS_XN), WSB(WS_WIN), MTOK, NPROJ, DM}; pg8::StaticOrder S; S.init(MTOK, NPROJ, F.G, (int)blockIdx.x);
        pg8::EpiStore E{WSB(WS_PROJ), NPROJ, 1.0f};
        pg8::gemm_phase<pg8::EpiStore, pg8::StaticOrder, true, true>(F.lds + RING_OFF, g, S, E);
    } SEAM(1);
    if (IN(2)) {
        p2_rope(F, A);
        for (int u = F.vcu; u < 256; u += F.G) compress_unit(F, A, u);
        { pg8::Gemm g{WSB(WS_MN), WSB(WS_WKV), MMEM, 2 * DM, DM}; pg8::StaticOrder S; S.init(MMEM, 2 * DM, F.G, (int)blockIdx.x);
          pg8::EpiStore E{WSB(WS_KVX), 2 * DM, 1.0f};
          pg8::gemm_phase<pg8::EpiStore, pg8::StaticOrder, true, true>(F.lds + RING_OFF, g, S, E); }
    } SEAM(2);
    if (IN(3)) {
        for (int p = F.vcu; p < 256; p += F.G) { const int b = p >> 5, s = p & 31; nsa_unit(F, A, b, 63 - s); nsa_unit(F, A, b, s); }
    } SEAM(3);
    if (IN(4)) {
        pg8::Gemm g{WSB(WS_MIXED), WSB(WS_WOUT), MTOK, DM, DM}; pg8::StaticOrder S; S.init(MTOK, DM, F.G, (int)blockIdx.x);
        pg8::EpiStore E{WSB(WS_Z), DM, 1.0f};
        pg8::gemm_phase<pg8::EpiStore, pg8::StaticOrder, true, true>(F.lds + RING_OFF, g, S, E);
    } SEAM(4);
    if (IN(5)) { resnorm_rows(F, WSB(WS_Z), INF(0), INF(15), A.out, INF(16), WSB(WS_XN)); } SEAM(5);
    if (IN(6)) {
        pg8::Gemm g{WSB(WS_XN), WSB(WS_WQ), MTOK, DM, DM}; pg8::StaticOrder S; S.init(MTOK, DM, F.G, (int)blockIdx.x);
        pg8::EpiStore E{WSB(WS_QX), DM, C2_X};
        pg8::gemm_phase<pg8::EpiStore, pg8::StaticOrder, true, true>(F.lds + RING_OFF, g, S, E);
    } SEAM(6);
    if (IN(7)) {
        for (int u = F.vcu; u < 512; u += F.G) { const int b = u >> 6, h = (u >> 4) & 3, qb = u & 15; xattn_unit(F, A, b, h, qb); }
    } SEAM(7);
    if (IN(8)) {
        pg8::Gemm g{WSB(WS_OX), WSB(WS_WO), MTOK, DM, DM}; pg8::StaticOrder S; S.init(MTOK, DM, F.G, (int)blockIdx.x);
        pg8::EpiStore E{WSB(WS_Z), DM, 1.0f};
        pg8::gemm_phase<pg8::EpiStore, pg8::StaticOrder, true, true>(F.lds + RING_OFF, g, S, E);
    } SEAM(8);
    if (IN(9)) { resnorm_rows(F, WSB(WS_Z), A.out, INF(21), A.out, INF(22), WSB(WS_XN)); } SEAM(9);
    if (IN(10)) {
        pg8::Gemm g{WSB(WS_XN), WSB(WS_WGU), MTOK, 2 * DFF, DM}; pg8::StaticOrder S; S.init(MTOK, 2 * DFF, F.G, (int)blockIdx.x);
        pg8::EpiSwiGLU E{WSB(WS_HB), DFF};
        pg8::gemm_phase<pg8::EpiSwiGLU, pg8::StaticOrder, true, true>(F.lds + RING_OFF, g, S, E);
    } SEAM(10);
    if (IN(11)) {
        pg8::Gemm g{WSB(WS_HB), WSB(WS_WD), MTOK, DM, DFF}; pg8::StaticOrder S; S.init(MTOK, DM, F.G, (int)blockIdx.x);
        pg8::EpiStore E{WSB(WS_Z), DM, 1.0f};
        pg8::gemm_phase<pg8::EpiStore, pg8::StaticOrder, true, true>(F.lds + RING_OFF, g, S, E);
    } SEAM(11);
    if (IN(12)) { resnorm_rows(F, WSB(WS_Z), A.out, INF(25), A.out, nullptr, nullptr); }
#undef IN
#undef SEAM
}

#ifndef MK_MULTI
#define MK_MULTI 0
#endif
extern "C" void kernel_launch(void* const* d_in, const int* in_sizes, int n_in, void* d_out, int out_size, void* d_ws, size_t ws_size, hipStream_t stream) {
    static int grid = 0;
    if (grid == 0) {
        if (n_in != 26 || in_sizes[0] != MTOK * DM || out_size != MTOK * DM || ws_size < WS_END) { fprintf(stderr, "kernel_launch: unexpected shapes (n_in %d, in0 %d, out %d, ws %zu); nothing launched\n", n_in, n_in > 0 ? in_sizes[0] : -1, out_size, ws_size); grid = -1; return; }
        int dev = 0, cus = 0, per_cu = 0;
        if (hipGetDevice(&dev) != hipSuccess || hipDeviceGetAttribute(&cus, hipDeviceAttributeMultiprocessorCount, dev) != hipSuccess) { grid = -1; return; }
        if (hipFuncSetAttribute((const void*)hymba_fwd, hipFuncAttributeMaxDynamicSharedMemorySize, LDS_BYTES) != hipSuccess) { fprintf(stderr, "kernel_launch: hipFuncSetAttribute failed\n"); grid = -1; return; }
        if (hipOccupancyMaxActiveBlocksPerMultiprocessor(&per_cu, (const void*)hymba_fwd, NWAVES * 64, LDS_BYTES) != hipSuccess || per_cu < 1)
            fprintf(stderr, "kernel_launch: note: occupancy query reports %d workgroups per CU\n", per_cu);
        (void)hipGetLastError();
        grid = cus;
    }
    if (grid < 0) return;
    if (hipMemsetAsync((char*)d_ws + WS_CTL, 0, CTL_ZERO_BYTES, stream) != hipSuccess) { fprintf(stderr, "kernel_launch: hipMemsetAsync failed\n"); return; }
    Args a{};
    for (int i = 0; i < 26; ++i) a.in[i] = d_in[i];
    a.out = (float*)d_out; a.ws = (unsigned char*)d_ws;
#if MK_MULTI
    for (int p = 0; p < N_PHASES; ++p) { a.ph_lo = p; a.ph_hi = p + 1; hipLaunchKernelGGL(hymba_fwd, dim3(grid), dim3(NWAVES * 64), LDS_BYTES, stream, a); }
#else
    a.ph_lo = 0; a.ph_hi = N_PHASES;
    hipLaunchKernelGGL(hymba_fwd, dim3(grid), dim3(NWAVES * 64), LDS_BYTES, stream, a);
#endif
    const hipError_t le = hipPeekAtLastError();
    if (le != hipSuccess) fprintf(stderr, "kernel_launch: launch failed: %s\n", hipGetErrorName(le));
}
```

```cpp
#ifndef GEMM_WGM
#define GEMM_WGM 8
#endif
#include <hip/hip_runtime.h>
#include <hip/hip_bf16.h>
#include <cstdio>
#include <cstdint>
#include <cmath>
namespace pg8 {
#define PG8_LAS __attribute__((address_space(3)))
typedef unsigned short bf16_t;
typedef short bf16x8 __attribute__((ext_vector_type(8)));
typedef float f32x4 __attribute__((ext_vector_type(4)));
typedef unsigned u32x4 __attribute__((ext_vector_type(4)));
constexpr int BM = 256, BK = 64, HALF = 128, HTB = HALF * BK * 2  , STAGE_BYTES = 8 * HTB, NXCD = 8, WGM = GEMM_WGM;

__host__ __device__ __forceinline__ int lds_byte(int r, int c) { const int st = (r >> 4) * 2 + (c >> 5), rr = r & 15, cc = c & 31, ob = rr * 64 + cc * 2; return st * 1024 + (ob ^ (((ob >> 9) & 1) << 5)); }
__host__ __device__ __forceinline__ void stage_rc(int b, int& R, int& C) { const int st = b / 1024, sb = b % 1024, swz = sb ^ (((sb >> 9) & 1) << 5); R = (st >> 1) * 16 + swz / 64; C = (st & 1) * 32 + (swz % 64) / 2; }
__host__ __device__ __forceinline__ int perm32(int rho) { const int n = rho >> 4, i = rho & 15; return 8 * (i >> 2) + 4 * n + (i & 3); }

struct Unit { int pm, pn; };
struct Gemm { const bf16_t* A; const bf16_t* Bt; int M, N, K; int lda, ldb; int ksA; };

struct StaticOrder {
    int nM, nN, nwg, G, c;
    __host__ __device__ void init(int M, int N, int G_, int c_) { nM = M / BM; nN = N / BM; nwg = nM * nN; G = G_; c = c_; }
    __host__ __device__ bool next(int i, Unit& u) const {
        const long L = (long)i * G + c; if (L >= nwg) return false;
        int wgid = (int)L; { const int q = nwg / NXCD, r = nwg % NXCD, xcd = wgid % NXCD, off = wgid / NXCD; wgid = (xcd < r ? xcd * (q + 1) : r * (q + 1) + (xcd - r) * q) + off; }
        const int nig = WGM * nN, gid = wgid / nig, fm = gid * WGM, gsz = (nM - fm) < WGM ? (nM - fm) : WGM;
        u.pm = fm + ((wgid % nig) % gsz); u.pn = (wgid % nig) / gsz; return true;
    }
    __device__ __forceinline__ void a_ready(const Unit&) const {}
    __device__ __forceinline__ void done(const Unit&) const {}
};

__device__ __forceinline__ unsigned cvt_pk_bf16(float lo, float hi) { unsigned r; asm volatile("v_cvt_pk_bf16_f32 %0, %1, %2" : "=v"(r) : "v"(lo), "v"(hi)); return r; }
__device__ __forceinline__ void store16_wt(void* p, u32x4 v) { asm volatile("global_store_dwordx4 %0, %1, off sc1\n\ts_nop 1" :: "v"(p), "v"(v) : "memory"); }
struct EpiStore {
    static constexpr bool PERM = true, AFTER_DRAIN = false;
    bf16_t* O; int ldc; float scale; const float* rscale; int nt_pn; int zlo, zhi, zcol; int rlo, rhi; const float* rtab;
    __device__ __forceinline__ void operator()(const f32x4 (&acc)[2][2][4][2], const Unit& u, int wr, int wc, int fr, int fq) const {
        const int row0 = u.pm * BM + wr * 64 + fr; const float sc = scale;
        if (u.pn >= zlo && u.pn < zhi) {
            const int zc0 = zcol + 128 * (u.pn - zlo) + wc * 32 + 8 * fq;
#pragma unroll
            for (int ai = 0; ai < 2; ++ai)
#pragma unroll
                for (int m = 0; m < 4; ++m) { const f32x4 v0 = acc[ai][0][m][0] * acc[ai][1][m][0], v1 = acc[ai][0][m][1] * acc[ai][1][m][1];
                    u32x4 w; w.x = cvt_pk_bf16(v0[0], v0[1]); w.y = cvt_pk_bf16(v0[2], v0[3]); w.z = cvt_pk_bf16(v1[0], v1[1]); w.w = cvt_pk_bf16(v1[2], v1[3]);
                    *(u32x4*)(O + (size_t)(row0 + ai * HALF + m * 16) * ldc + zc0) = w; }
            return; }
        const int col0 = u.pn * BM + wc * 64 + 8 * fq;
        if (u.pn >= rlo && u.pn < rhi && wc < 2) {
#pragma unroll
            for (int ai = 0; ai < 2; ++ai)
#pragma unroll
                for (int m = 0; m < 4; ++m) { const int row = row0 + ai * HALF + m * 16; const float* tb = rtab + (size_t)row * 64 + 8 * fq;
                    const f32x4 c0 = *(const f32x4*)tb, c1 = *(const f32x4*)(tb + 4), s0 = *(const f32x4*)(tb + 32), s1 = *(const f32x4*)(tb + 36);
                    const f32x4 a0 = acc[ai][0][m][0], a1 = acc[ai][0][m][1], b0 = acc[ai][1][m][0], b1 = acc[ai][1][m][1];
                    const f32x4 o0 = a0 * c0 - b0 * s0, o1 = a1 * c1 - b1 * s1, p0 = b0 * c0 + a0 * s0, p1 = b1 * c1 + a1 * s1;
                    bf16_t* rowp = O + (size_t)row * ldc + col0;
                    u32x4 w; w.x = cvt_pk_bf16(o0[0], o0[1]); w.y = cvt_pk_bf16(o0[2], o0[3]); w.z = cvt_pk_bf16(o1[0], o1[1]); w.w = cvt_pk_bf16(o1[2], o1[3]);
                    *(u32x4*)rowp = w;
                    w.x = cvt_pk_bf16(p0[0], p0[1]); w.y = cvt_pk_bf16(p0[2], p0[3]); w.z = cvt_pk_bf16(p1[0], p1[1]); w.w = cvt_pk_bf16(p1[2], p1[3]);
                    *(u32x4*)(rowp + 32) = w; }
            return; }
#pragma unroll
        for (int ai = 0; ai < 2; ++ai)
#pragma unroll
            for (int m = 0; m < 4; ++m) { bf16_t* rowp = O + (size_t)(row0 + ai * HALF + m * 16) * ldc + col0; const float rs = rscale ? sc * rscale[row0 + ai * HALF + m * 16] : sc;
#pragma unroll
                for (int bj = 0; bj < 2; ++bj) { const f32x4 v0 = acc[ai][bj][m][0] * rs, v1 = acc[ai][bj][m][1] * rs;
                    u32x4 w; w.x = cvt_pk_bf16(v0[0], v0[1]); w.y = cvt_pk_bf16(v0[2], v0[3]); w.z = cvt_pk_bf16(v1[0], v1[1]); w.w = cvt_pk_bf16(v1[2], v1[3]);
                    if (u.pn < nt_pn) __builtin_nontemporal_store(w, (u32x4*)(rowp + bj * 32)); else *(u32x4*)(rowp + bj * 32) = w; } }
    }
};
__device__ __forceinline__ float silu_f(float x) { return x * __builtin_amdgcn_rcpf(1.0f + __builtin_amdgcn_exp2f(-1.4426950408889634f * x)); }
struct EpiSwiGLU {
    static constexpr bool PERM = true, AFTER_DRAIN = false;
    bf16_t* O; int ldc;
    __device__ __forceinline__ void operator()(const f32x4 (&acc)[2][2][4][2], const Unit& u, int wr, int wc, int fr, int fq) const {
        const int row0 = u.pm * BM + wr * 64 + fr; const int col0 = u.pn * HALF + wc * 32 + 8 * fq;
#ifdef HB_TILED
        bf16_t* tp = O + ((size_t)(u.pm * (ldc / 64) + 2 * u.pn + (wc >> 1)) * BM + wr * 64 + fr) * 64 + (wc & 1) * 32 + 8 * fq;
#endif
#pragma unroll
        for (int ai = 0; ai < 2; ++ai)
#pragma unroll
            for (int m = 0; m < 4; ++m) {
#ifdef HB_TILED
                bf16_t* rowp = tp + (ai * HALF + m * 16) * 64;
#else
                bf16_t* rowp = O + (size_t)(row0 + ai * HALF + m * 16) * ldc + col0;
#endif
                const f32x4 g0 = acc[ai][0][m][0], g1 = acc[ai][0][m][1], u0 = acc[ai][1][m][0], u1 = acc[ai][1][m][1];
                float h[8];
#pragma unroll
                for (int e = 0; e < 4; ++e) { h[e] = silu_f(g0[e]) * u0[e]; h[4 + e] = silu_f(g1[e]) * u1[e]; }
                u32x4 w; w.x = cvt_pk_bf16(h[0], h[1]); w.y = cvt_pk_bf16(h[2], h[3]); w.z = cvt_pk_bf16(h[4], h[5]); w.w = cvt_pk_bf16(h[6], h[7]);
#ifdef HB_NT
                __builtin_nontemporal_store(w, (u32x4*)rowp); }
#else
                *(u32x4*)rowp = w; }
#endif
    }
};

struct HybridOrder {
    StaticOrder so; bool xm; int nN, ppx, vx, vr, rev;
    __host__ __device__ void init(int M, int N, int G, int c, int vx_, int vr_) { so.init(M, N, G, c); nN = N / BM; ppx = (M / BM) / 8; vx = vx_; vr = vr_; rev = 0; xm = (G == 256) && ((M / BM) % 8 == 0); }
    __host__ __device__ bool next(int i, Unit& u) const {
        if (!xm) return so.next(i, u);
        const int idx = i * 32 + vr, per = ppx * nN; if (idx >= per) return false;
        const int gsz = ppx < WGM ? ppx : WGM, gunits = gsz * nN, g2 = idx / gunits, w = idx - g2 * gunits;
        u.pm = vx * ppx + (rev ? ppx / gsz - 1 - g2 : g2) * gsz + (w % gsz); u.pn = w / gsz; return true;
    }
    __device__ __forceinline__ void a_ready(const Unit&) const {}
    __device__ __forceinline__ void done(const Unit&) const {}
};
struct FixedUnit { int pm, pn, pm1, pn1;
    __host__ __device__ bool next(int i, Unit& u) const { if (i == 0) { u.pm = pm; u.pn = pn; return true; } if (i == 1 && pm1 >= 0) { u.pm = pm1; u.pn = pn1; return true; } return false; }
    __device__ __forceinline__ void a_ready(const Unit&) const {}
    __device__ __forceinline__ void done(const Unit&) const {} };
struct EpiSoftmax {
    static constexpr bool PERM = true, AFTER_DRAIN = false;
    bf16_t* O; int ldc; PG8_LAS float* tab;
    __device__ __forceinline__ void operator()(const f32x4 (&acc_)[2][2][4][2], const Unit& u, int wr, int wc, int fr, int fq) const {
        f32x4 (&acc)[2][2][4][2] = const_cast<f32x4 (&)[2][2][4][2]>(acc_);
        PG8_LAS float* MX = tab; PG8_LAS float* SM = tab + 1024;
        const int rl0 = wr * 64 + fr;
#pragma unroll
        for (int ai = 0; ai < 2; ++ai)
#pragma unroll
            for (int m = 0; m < 4; ++m) { float mx = -INFINITY;
#pragma unroll
                for (int bj = 0; bj < 2; ++bj)
#pragma unroll
                    for (int n = 0; n < 2; ++n) { const f32x4 x = acc[ai][bj][m][n]; mx = fmaxf(mx, fmaxf(fmaxf(x[0], x[1]), fmaxf(x[2], x[3]))); }
                mx = fmaxf(mx, __shfl_xor(mx, 16)); mx = fmaxf(mx, __shfl_xor(mx, 32));
                if (fq == 0) MX[(ai * HALF + m * 16 + rl0) * 4 + wc] = mx; }
        asm volatile("s_waitcnt lgkmcnt(0)" ::: "memory"); __builtin_amdgcn_s_barrier(); asm volatile("" ::: "memory");
#pragma unroll
        for (int ai = 0; ai < 2; ++ai)
#pragma unroll
            for (int m = 0; m < 4; ++m) { const f32x4 m4 = *(const PG8_LAS f32x4*)(MX + (ai * HALF + m * 16 + rl0) * 4); const float rm = fmaxf(fmaxf(m4[0], m4[1]), fmaxf(m4[2], m4[3])); float ps = 0.f;
#pragma unroll
                for (int bj = 0; bj < 2; ++bj)
#pragma unroll
                    for (int n = 0; n < 2; ++n) { f32x4 x = acc[ai][bj][m][n];
                        x[0] = __builtin_amdgcn_exp2f(x[0] - rm); x[1] = __builtin_amdgcn_exp2f(x[1] - rm); x[2] = __builtin_amdgcn_exp2f(x[2] - rm); x[3] = __builtin_amdgcn_exp2f(x[3] - rm);
                        ps += (x[0] + x[1]) + (x[2] + x[3]); acc[ai][bj][m][n] = x; }
                ps += __shfl_xor(ps, 16); ps += __shfl_xor(ps, 32);
                if (fq == 0) SM[(ai * HALF + m * 16 + rl0) * 4 + wc] = ps; }
        asm volatile("s_waitcnt lgkmcnt(0)" ::: "memory"); __builtin_amdgcn_s_barrier(); asm volatile("" ::: "memory");
        const int col0 = u.pn * BM + wc * 64 + 8 * fq;
#pragma unroll
        for (int ai = 0; ai < 2; ++ai)
#pragma unroll
            for (int m = 0; m < 4; ++m) { const f32x4 s4 = *(const PG8_LAS f32x4*)(SM + (ai * HALF + m * 16 + rl0) * 4); const float inv = 1.0f / ((s4[0] + s4[1]) + (s4[2] + s4[3]));
                bf16_t* rowp = O + (size_t)(u.pm * BM + ai * HALF + m * 16 + rl0) * ldc + col0;
#pragma unroll
                for (int bj = 0; bj < 2; ++bj) { const f32x4 v0 = acc[ai][bj][m][0] * inv, v1 = acc[ai][bj][m][1] * inv;
                    u32x4 w; w.x = cvt_pk_bf16(v0[0], v0[1]); w.y = cvt_pk_bf16(v0[2], v0[3]); w.z = cvt_pk_bf16(v1[0], v1[1]); w.w = cvt_pk_bf16(v1[2], v1[3]);
                    *(u32x4*)(rowp + bj * 32) = w; } }
    }
};
template <class Epi, class Sched, bool ALIGN_EPI = false, bool SP2 = false, int A_AUX = 0  >
__device__ __forceinline__ void gemm_phase(PG8_LAS unsigned char* lds, const Gemm g, const Sched& S, const Epi& E) {
    const int tid = threadIdx.x, wid = __builtin_amdgcn_readfirstlane(tid >> 6), lane = tid & 63, wr = wid >> 2, wc = wid & 3, fr = lane & 15, fq = lane >> 4;
    const int K = g.K, nt = K / BK, lda = g.lda ? g.lda : K, ldb = g.ldb ? g.ldb : K;
    unsigned voffA[2], voffB[2];
#pragma unroll
    for (int i = 0; i < 2; ++i) { int R, C; stage_rc(tid * 16 + i * 8192, R, C); const int Rb = Epi::PERM ? ((R & ~31) + perm32(R & 31)) : R;
        voffA[i] = (unsigned)(R * lda + C) * 2u; voffB[i] = (unsigned)(Rb * ldb + C) * 2u; }
    const size_t kstep = (size_t)(BK * 2);
    const size_t hstepA = (size_t)HALF * lda * 2, hstepB = (size_t)HALF * ldb * 2;
    const size_t kstepA = g.ksA ? (size_t)g.ksA : kstep;
    const size_t tstepA = g.ksA ? (size_t)nt * g.ksA : 2 * hstepA, tstepB = 2 * hstepB;
    const unsigned ldsw = (unsigned)wid * 1024u;
    const int aoff = lds_byte(wr * 64 + fr, fq * 8), boff = lds_byte(wc * 32 + fr, fq * 8);
#define PG8_SA(b, h) (((b) * 2 + (h)) * HTB)
#define PG8_SB(b, h) ((4 + (b) * 2 + (h)) * HTB)
#define PG8_STAGE(bufoff, gbase, voff) do { _Pragma("unroll") for (int _i = 0; _i < 2; ++_i) \
        __builtin_amdgcn_global_load_lds((const unsigned*)((const char*)(gbase) + (voff)[_i]), (PG8_LAS unsigned*)(lds + (bufoff) + ldsw + _i * 8192), 16, 0, 0); } while (0)
#define PG8_STAGEA(bufoff, gbase, voff) do { _Pragma("unroll") for (int _i = 0; _i < 2; ++_i) \
        __builtin_amdgcn_global_load_lds((const unsigned*)((const char*)(gbase) + (voff)[_i]), (PG8_LAS unsigned*)(lds + (bufoff) + ldsw + _i * 8192), 16, 0, A_AUX); } while (0)
#define PG8_LDA(dst, b, h) do { _Pragma("unroll") for (int m = 0; m < 4; ++m) _Pragma("unroll") for (int k = 0; k < 2; ++k) dst[m][k] = *(const PG8_LAS bf16x8*)(lds + PG8_SA(b, h) + aoff + m * 2048 + k * 1024); } while (0)
#define PG8_LDB(dst, b, h) do { _Pragma("unroll") for (int n = 0; n < 2; ++n) _Pragma("unroll") for (int k = 0; k < 2; ++k) dst[n][k] = *(const PG8_LAS bf16x8*)(lds + PG8_SB(b, h) + boff + n * 2048 + k * 1024); } while (0)
#define PG8_MMA(ai, bj, At, Bt) do { __builtin_amdgcn_s_setprio(1); _Pragma("unroll") for (int m = 0; m < 4; ++m) _Pragma("unroll") for (int n = 0; n < 2; ++n) _Pragma("unroll") for (int k = 0; k < 2; ++k) \
        acc[ai][bj][m][n] = __builtin_amdgcn_mfma_f32_16x16x32_bf16(Bt[n][k], At[m][k], acc[ai][bj][m][n], 0, 0, 0); __builtin_amdgcn_s_setprio(0); } while (0)
#define PG8_WAIT_V(n) asm volatile("s_waitcnt vmcnt(" #n ")" ::: "memory")
#define PG8_WAIT_L(n) asm volatile("s_waitcnt lgkmcnt(" #n ")" ::: "memory")
#define PG8_BAR __builtin_amdgcn_s_barrier()
#define PG8_SCHED __builtin_amdgcn_sched_barrier(0)
    Unit cur, nxt; int ui = 0;
    if (!S.next(0, cur)) return;
    f32x4 acc[2][2][4][2];
#pragma unroll
    for (int a = 0; a < 2; ++a)
#pragma unroll
        for (int b = 0; b < 2; ++b)
#pragma unroll
            for (int m = 0; m < 4; ++m)
#pragma unroll
                for (int n = 0; n < 2; ++n) acc[a][b][m][n] = (f32x4){0.f, 0.f, 0.f, 0.f};
    bf16x8 At[4][2], B0[2][2], B1[2][2];
    const char* cA = (const char*)g.A + (size_t)cur.pm * tstepA; const char* cB = (const char*)g.Bt + (size_t)cur.pn * tstepB;
    S.a_ready(cur);
    if constexpr (SP2) {
        PG8_STAGE(PG8_SB(0, 0), cB, voffB); PG8_STAGE(PG8_SB(0, 1), cB + hstepB, voffB); PG8_STAGEA(PG8_SA(0, 0), cA, voffA); PG8_STAGEA(PG8_SA(0, 1), cA + hstepA, voffA);
        if (wr == 1) PG8_BAR;
        PG8_WAIT_V(2); PG8_BAR;
        PG8_STAGE(PG8_SB(1, 0), cB + kstep, voffB); PG8_STAGEA(PG8_SA(1, 0), cA + kstepA, voffA); PG8_STAGE(PG8_SB(1, 1), cB + hstepB + kstep, voffB);
        PG8_WAIT_V(6); PG8_BAR;
    } else {
        PG8_STAGE(PG8_SB(0, 0), cB, voffB); PG8_STAGEA(PG8_SA(0, 0), cA, voffA); PG8_STAGE(PG8_SB(0, 1), cB + hstepB, voffB); PG8_STAGEA(PG8_SA(0, 1), cA + hstepA, voffA);
        if (wr == 1) PG8_BAR;
        PG8_WAIT_V(4); PG8_BAR;
        PG8_STAGE(PG8_SB(1, 0), cB + kstep, voffB); PG8_STAGEA(PG8_SA(1, 0), cA + kstepA, voffA); PG8_STAGE(PG8_SB(1, 1), cB + hstepB + kstep, voffB);
        PG8_WAIT_V(6); PG8_BAR;
    }
    for (;;) {
        const bool has_next = S.next(ui + 1, nxt);
        const char* nA = has_next ? (const char*)g.A + (size_t)nxt.pm * tstepA : cA; const char* nB = has_next ? (const char*)g.Bt + (size_t)nxt.pn * tstepB : cB;
        for (int t = 0; t < nt; t += 2) {
            const bool last = (t == nt - 2);
            const char* a1 = cA + (size_t)(t + 1) * kstepA;
            const char* a2 = last ? nA : cA + (size_t)(t + 2) * kstepA; const char* b2 = last ? nB : cB + (size_t)(t + 2) * kstep;
            const char* a3 = a2 + kstepA; const char* b3 = b2 + kstep;
            if (last && has_next) S.a_ready(nxt);
            if constexpr (SP2) {
            PG8_LDB(B0, 0, 0); PG8_LDB(B1, 0, 1); PG8_SCHED; PG8_LDA(At, 0, 0); PG8_STAGEA(PG8_SA(1, 1), a1 + hstepA, voffA);
            PG8_WAIT_V(8); PG8_WAIT_L(0); PG8_BAR; PG8_MMA(0, 0, At, B0); PG8_MMA(0, 1, At, B1); PG8_BAR; PG8_SCHED;
            PG8_LDA(At, 0, 1); PG8_STAGE(PG8_SB(0, 0), b2, voffB); PG8_STAGE(PG8_SB(0, 1), b2 + hstepB, voffB); PG8_STAGEA(PG8_SA(0, 0), a2, voffA);
            PG8_WAIT_V(8); PG8_WAIT_L(0); PG8_BAR; PG8_MMA(1, 0, At, B0); PG8_MMA(1, 1, At, B1); PG8_BAR; PG8_SCHED;
            PG8_LDB(B0, 1, 0); PG8_LDB(B1, 1, 1); PG8_SCHED; PG8_LDA(At, 1, 0); PG8_STAGEA(PG8_SA(0, 1), a2 + hstepA, voffA);
            PG8_WAIT_V(8); PG8_WAIT_L(0); PG8_BAR; PG8_MMA(0, 0, At, B0); PG8_MMA(0, 1, At, B1); PG8_BAR; PG8_SCHED;
            PG8_LDA(At, 1, 1); PG8_STAGE(PG8_SB(1, 0), b3, voffB); PG8_STAGE(PG8_SB(1, 1), b3 + hstepB, voffB); PG8_STAGEA(PG8_SA(1, 0), a3, voffA);
            PG8_WAIT_V(8); PG8_WAIT_L(0); PG8_BAR; PG8_MMA(1, 0, At, B0); PG8_MMA(1, 1, At, B1); PG8_BAR; PG8_SCHED;
            } else {
            PG8_LDB(B0, 0, 0); PG8_SCHED; PG8_LDA(At, 0, 0); PG8_STAGEA(PG8_SA(1, 1), a1 + hstepA, voffA);
            PG8_WAIT_L(8); PG8_BAR; PG8_WAIT_L(0); PG8_MMA(0, 0, At, B0); PG8_BAR; PG8_SCHED;
            PG8_LDB(B1, 0, 1); PG8_STAGE(PG8_SB(0, 0), b2, voffB);
            PG8_BAR; PG8_WAIT_L(0); PG8_MMA(0, 1, At, B1); PG8_BAR;
            PG8_LDA(At, 0, 1); PG8_STAGEA(PG8_SA(0, 0), a2, voffA);
            PG8_BAR; PG8_WAIT_L(0); PG8_MMA(1, 0, At, B0); PG8_BAR; PG8_SCHED;
            PG8_STAGE(PG8_SB(0, 1), b2 + hstepB, voffB);
            PG8_WAIT_V(6); PG8_BAR; PG8_MMA(1, 1, At, B1); PG8_BAR;
            PG8_LDB(B0, 1, 0); PG8_SCHED; PG8_LDA(At, 1, 0); PG8_STAGEA(PG8_SA(0, 1), a2 + hstepA, voffA);
            PG8_WAIT_L(8); PG8_BAR; PG8_WAIT_L(0); PG8_MMA(0, 0, At, B0); PG8_BAR; PG8_SCHED;
            PG8_LDB(B1, 1, 1); PG8_STAGE(PG8_SB(1, 0), b3, voffB);
            PG8_BAR; PG8_WAIT_L(0); PG8_MMA(0, 1, At, B1); PG8_BAR;
            PG8_LDA(At, 1, 1); PG8_STAGEA(PG8_SA(1, 0), a3, voffA);
            PG8_BAR; PG8_WAIT_L(0); PG8_MMA(1, 0, At, B0); PG8_BAR; PG8_SCHED;
            PG8_STAGE(PG8_SB(1, 1), b3 + hstepB, voffB);
            PG8_WAIT_V(6); PG8_BAR; PG8_MMA(1, 1, At, B1); PG8_BAR;
            }
        }
        if constexpr (ALIGN_EPI) { if (wr == 0) PG8_BAR; }
        if constexpr (!Epi::AFTER_DRAIN) { E(acc, cur, wr, wc, fr, fq); S.done(cur); }
        if (!has_next) break;
#pragma unroll
        for (int a = 0; a < 2; ++a)
#pragma unroll
            for (int b = 0; b < 2; ++b)
#pragma unroll
                for (int m = 0; m < 4; ++m)
#pragma unroll
                    for (int n = 0; n < 2; ++n) acc[a][b][m][n] = (f32x4){0.f, 0.f, 0.f, 0.f};
        cur = nxt; cA = nA; cB = nB; ++ui;
        if constexpr (ALIGN_EPI) { if (wr == 1) PG8_BAR; }
    }
    PG8_WAIT_V(0);
    if constexpr (!ALIGN_EPI) { if (wr == 0) PG8_BAR; }
    PG8_BAR;
    if constexpr (Epi::AFTER_DRAIN) { E.fused(acc, cur, wr, wc, fr, fq, lds, wid, lane); S.done(cur); }
#undef PG8_SA
#undef PG8_SB
#undef PG8_STAGE
#undef PG8_STAGEA
#undef PG8_LDA
#undef PG8_LDB
#undef PG8_MMA
#undef PG8_WAIT_V
#undef PG8_WAIT_L
#undef PG8_BAR
#undef PG8_SCHED
}
}

constexpr int NWAVES = 8;
constexpr int BATCH = 8, SEQ = 4096, DM = 1024, MTOK = BATCH * SEQ;
constexpr int MEM_LEN = 256, MMEM = BATCH * MEM_LEN;
constexpr int W_IN_COLS = 2840, NPROJ = 3072, DFF = 2816;
constexpr int COL_BG = 0, COL_CG = 512, COL_XIN = 1024, COL_Q = 1536, COL_KC = 2048, COL_VC = 2176, COL_KSL = 2304, COL_VSL = 2432, COL_KW = 2560, COL_VW = 2688, COL_GL = 2816;
constexpr float EPS = 1e-6f;
constexpr float LOG2E = 1.4426950408889634f;
constexpr float C2_NSA = 0.125f * LOG2E;
constexpr float C2_X = 0.0625f * LOG2E;

constexpr size_t MiB = 1u << 20;
#if defined(MK_MULTI) && MK_MULTI
constexpr size_t WS_CTL = 0, CTL_ZERO_BYTES = 256 * 1024;
#else
constexpr size_t WS_CTL = 0, CTL_ZERO_BYTES = 64 * 1024;
#endif
constexpr size_t WS_BIAS = 512 * 1024;
constexpr size_t WS_WIN = 2 * MiB, WS_W1KC = 8 * MiB, WS_W1VC = 9 * MiB, WS_W2KC = 10 * MiB, WS_W2VC = 10 * MiB + 512 * 1024;
constexpr size_t WS_WOUT = 11 * MiB, WS_WQ = 13 * MiB, WS_WKV = 15 * MiB, WS_WO = 19 * MiB, WS_WGU = 21 * MiB, WS_WD = 32 * MiB;
constexpr size_t WS_MN = 38 * MiB, WS_KVX = 42 * MiB, WS_KCMP = 50 * MiB, WS_VCMP = 51 * MiB, WS_BPART = 51 * MiB + 512 * 1024, WS_ROPE = 52 * MiB, WS_RSTD = 60 * MiB, WS_SQ = 61 * MiB;
constexpr size_t WS_XN = 64 * MiB, WS_H = WS_XN, WS_PROJ = 128 * MiB, WS_HB = WS_PROJ, WS_MIXED = 320 * MiB, WS_QX = WS_MIXED, WS_Z = 384 * MiB, WS_MBT = 448 * MiB, WS_NBT = 464 * MiB, WS_END = 512 * MiB;
#ifndef HB_PITCH
#define HB_PITCH DFF
#endif
constexpr size_t HB_BATCH_SHIFT = (size_t)SEQ * (NPROJ - HB_PITCH);
constexpr int CW_BAR = 4096;

constexpr int RING_OFF = 0, RING_BYTES = 131072;
constexpr int WSF_OFF = RING_BYTES;
constexpr int LDS_BYTES = 147456;
constexpr int LDSCTL_OFF = LDS_BYTES - 512, MISC_OFF = LDSCTL_OFF + 320;
static_assert(MISC_OFF + 128 <= LDS_BYTES, "LDS map");

#define GAS __attribute__((address_space(1)))
#define LAS __attribute__((address_space(3)))
typedef unsigned short bf16;
typedef unsigned v4u __attribute__((ext_vector_type(4)));
typedef float f32x4 __attribute__((ext_vector_type(4)));
typedef short bf16x8 __attribute__((ext_vector_type(8)));
typedef GAS unsigned gu32;
typedef GAS unsigned long long gu64;
#define RLX_AGENT __ATOMIC_RELAXED, __HIP_MEMORY_SCOPE_AGENT
#define LDS_WAIT() asm volatile("s_waitcnt lgkmcnt(0)" ::: "memory")
#define VM_WAIT() asm volatile("s_waitcnt vmcnt(0)" ::: "memory")
__device__ __forceinline__ unsigned long long rt() { return __builtin_amdgcn_s_memrealtime(); }
__device__ __forceinline__ unsigned f2bf(float f) { unsigned u = __builtin_bit_cast(unsigned, f); return (u + 0x7fffu + ((u >> 16) & 1u)) >> 16; }
__device__ __forceinline__ unsigned pk2(float lo, float hi) { return f2bf(lo) | (f2bf(hi) << 16); }
#define XB_TMO      128
#define XB_XCNT(j)  (256  + 64 * (j))
#define XB_XSUB(j)  (1280 + 64 * (j))
#define XB_XGEN(j)  (2304 + 64 * (j))
#define XB_TOP      3328
#define XB_TOPGEN   3392
#define XCD_BAR_WORDS 3456
#define XB_SPIN_CAP (1u << 18)

__device__ __forceinline__ unsigned xb_ld(unsigned* p)              { return __hip_atomic_load(p, __ATOMIC_RELAXED, __HIP_MEMORY_SCOPE_AGENT); }
__device__ __forceinline__ unsigned xb_add(unsigned* p, unsigned v) { return __hip_atomic_fetch_add(p, v, __ATOMIC_RELAXED, __HIP_MEMORY_SCOPE_AGENT); }
__device__ __forceinline__ unsigned xb_xcc_id() { return (unsigned)__builtin_amdgcn_s_getreg((3 << 11) | 20) & 0xFu; }
#define XB_SPIN(cond, bar) do { unsigned _sp = 0; while (cond) { __builtin_amdgcn_s_sleep(1); \
    if ((++_sp & 255u) == 0u) { if (xb_ld(&(bar)[XB_TMO])) break; if (_sp > XB_SPIN_CAP) { atomicAdd(&(bar)[XB_TMO], 1u); break; } } } } while (0)

struct XcdBarrier {
    unsigned* bar; unsigned x;
    volatile LAS unsigned* st;
};

__device__ __forceinline__ XcdBarrier xcd_barrier_post(unsigned* bar, volatile LAS unsigned* st) {
    XcdBarrier b; b.bar = bar; b.x = xb_xcc_id(); b.st = st;
    if (threadIdx.x == 0) st[3] = xb_add(&bar[XB_XCNT(b.x)], 1u);
    return b;
}
__device__ __forceinline__ void xcd_barrier_complete(unsigned* bar, unsigned x, unsigned& nloc, unsigned& nx, unsigned& ok32) {
    const unsigned G = gridDim.x * gridDim.y * gridDim.z;
    unsigned sum, cnt, mine, c32, sp = 0u;
    for (;;) {
        sum = 0u; cnt = 0u; mine = 0u; c32 = 0u;
#pragma unroll
        for (unsigned j = 0; j < 16; ++j) { const unsigned c = xb_ld(&bar[XB_XCNT(j)]); sum += c; cnt += (c > 0u) ? 1u : 0u; c32 += (j < 8u && c == 32u) ? 1u : 0u; mine = (j == x) ? c : mine; }
        if (sum == G) break;
        __builtin_amdgcn_s_sleep(1);
        if ((++sp & 255u) == 0u) { if (xb_ld(&bar[XB_TMO])) break; if (sp > XB_SPIN_CAP) { atomicAdd(&bar[XB_TMO], 1u); break; } }
    }
    nloc = mine > 0u ? mine : 1u; nx = cnt > 0u ? cnt : 1u;
    ok32 = (sum == G && G == 256u && cnt == 8u && c32 == 8u && xb_ld(&bar[XB_TMO]) == 0u) ? 1u : 0u;
}

__device__ __forceinline__ void xcd_barrier(const XcdBarrier& b, bool local = false) {
    asm volatile("s_waitcnt vmcnt(0)" ::: "memory");
    __syncthreads();
    if (threadIdx.x == 0) {
        unsigned* bar = b.bar;
        __builtin_amdgcn_s_waitcnt(0);
        unsigned nloc = b.st[0], nx = b.st[1];
        if (nloc == 0u) { unsigned ok32; xcd_barrier_complete(bar, b.x, nloc, nx, ok32); b.st[0] = nloc; b.st[1] = nx; b.st[2] = ok32; }
        const unsigned rnd = b.st[4]; b.st[4] = rnd + 1u;
        if (local) {
            __hip_atomic_fetch_add(&bar[XB_XSUB(b.x)], 1u, __ATOMIC_RELAXED, __HIP_MEMORY_SCOPE_AGENT);
            const unsigned target = (rnd + 1u) * nloc;
            XB_SPIN(xb_ld(&bar[XB_XSUB(b.x)]) < target, bar);
            __builtin_amdgcn_fence(__ATOMIC_ACQUIRE, "agent");
            asm volatile("s_waitcnt vmcnt(0)" ::: "memory");
        } else {
        const unsigned old = xb_add(&bar[XB_XSUB(b.x)], 1u);
        const unsigned gen = b.st[5]; b.st[5] = gen + 1u;
        if (old + 1u == (rnd + 1u) * nloc) {
          {
            __builtin_amdgcn_fence(__ATOMIC_RELEASE, "agent");
            asm volatile("s_waitcnt vmcnt(0)" ::: "memory");
            const unsigned og = xb_add(&bar[XB_TOP], 1u);
            const unsigned tg = og / nx;
            if (og + 1u == (tg + 1u) * nx) xb_add(&bar[XB_TOPGEN], 1u);
            else XB_SPIN(xb_ld(&bar[XB_TOPGEN]) == tg, bar);
          }
            __builtin_amdgcn_fence(__ATOMIC_ACQUIRE, "agent");
            xb_add(&bar[XB_XGEN(b.x)], 1u);
            asm volatile("s_waitcnt vmcnt(0)" ::: "memory");
        } else {
            XB_SPIN(xb_ld(&bar[XB_XGEN(b.x)]) == gen, bar);
            __builtin_amdgcn_fence(__ATOMIC_ACQUIRE, "agent");
            asm volatile("s_waitcnt vmcnt(0)" ::: "memory");
        }
        }
    }
    __syncthreads();
}

typedef float f32x16 __attribute__((ext_vector_type(16)));
typedef short s16x4 __attribute__((ext_vector_type(4)));
typedef float f32x2_t __attribute__((ext_vector_type(2)));
typedef __bf16 bf16x2_t __attribute__((ext_vector_type(2)));
typedef LAS char lchar;
#define SBAR() __builtin_amdgcn_sched_barrier(0)
__device__ __forceinline__ float bf2f(unsigned short h) { return __uint_as_float((unsigned)h << 16); }
__device__ __forceinline__ float bflo(unsigned w) { return __uint_as_float(w << 16); }
__device__ __forceinline__ float bfhi(unsigned w) { return __uint_as_float(w & 0xffff0000u); }
__device__ __forceinline__ unsigned cvtpk(float lo, float hi) { f32x2_t v = {lo, hi}; bf16x2_t b = __builtin_convertvector(v, bf16x2_t); return __builtin_bit_cast(unsigned, b); }
__device__ __forceinline__ float wave_sum(float v) {
#pragma unroll
    for (int o = 1; o < 64; o <<= 1) v += __shfl_xor(v, o);
    return v;
}
__device__ __forceinline__ int crow(int r, int hi) { return (r & 3) + 8 * (r >> 2) + 4 * hi; }
__device__ __forceinline__ float pair_max(float a) { auto rr = __builtin_amdgcn_permlane32_swap(__float_as_uint(a), __float_as_uint(a), false, false); return fmaxf(__uint_as_float(rr[0]), __uint_as_float(rr[1])); }
__device__ __forceinline__ float pair_sum(float a) { auto rr = __builtin_amdgcn_permlane32_swap(__float_as_uint(a), __float_as_uint(a), false, false); return __uint_as_float(rr[0]) + __uint_as_float(rr[1]); }
__device__ __forceinline__ f32x16 mfma32(bf16x8 a, bf16x8 b, f32x16 c) { return __builtin_amdgcn_mfma_f32_32x32x16_bf16(a, b, c, 0, 0, 0); }

struct Frame {
    LAS unsigned char* lds;
    volatile LAS unsigned* MISC;
    gu32* ctl;
    int tid, lane, wave;
    int vcu, G;
    int vx, vr;
};
struct Args { const void* in[26]; float* out; unsigned char* ws; int ph_lo, ph_hi, bar_region, pad; };
#define INF(i) ((const float*)A.in[i])
#define WSB(off) ((bf16*)(A.ws + (off)))

namespace ab {
using bf16=__hip_bfloat16;
using u32x4=__attribute__((ext_vector_type(4)))unsigned;
constexpr int PITCH=NPROJ;
constexpr int NW=8,QBLK=32,KVBLK=64;
constexpr int NSLOT=3, SLOTB=8192;
constexpr int LDS_K=0, LDS_V=NSLOT*SLOTB, LDS_WS=2*NSLOT*SLOTB, LDS_END=LDS_WS+NW*64*4;
__device__ __forceinline__ void glds16(const void*gsrc,unsigned lds_dst){unsigned keep;
  asm volatile("s_mov_b32 %0, m0\n\ts_mov_b32 m0, %2\n\ts_nop 0\n\tglobal_load_lds_dwordx4 %1, off\n\ts_mov_b32 m0, %0":"=&s"(keep):"v"(gsrc),"s"(lds_dst):"memory");}
__device__ __forceinline__ float max3f(float a,float b,float c){float r;asm("v_max3_f32 %0, %1, %2, %3":"=v"(r):"v"(a),"v"(b),"v"(c));return r;}
__device__ __forceinline__ float max2f(float a,float b){float r;asm("v_max_f32_e32 %0, %1, %2":"=v"(r):"v"(a),"v"(b));return r;}
__device__ __forceinline__ float fadd_s(float a,float b){float r;asm("v_add_f32_e32 %0, %1, %2":"=v"(r):"v"(a),"v"(b));return r;}
__device__ __forceinline__ float fsub_s(float a,float b){float r;asm("v_sub_f32_e32 %0, %1, %2":"=v"(r):"v"(a),"v"(b));return r;}
__device__ __forceinline__ unsigned cvtpk_s(float lo,float hi){f32x2_t v={lo,hi};bf16x2_t b=__builtin_convertvector(v,bf16x2_t);return __builtin_bit_cast(unsigned,b);}
#define WAIT_BAR(N) asm volatile("s_waitcnt vmcnt(" #N ") lgkmcnt(0)\n\ts_barrier":::"memory")

__device__ __forceinline__ void qkt(f32x16&p0,f32x16&p1,const char*Kslot,const bf16x8*qr,const f32x16&negm,int r32,int hi){
  const char*kb=Kslot+hi*1024+r32*16;
  #pragma unroll
  for(int d0=0;d0<4;++d0){
    const bf16x8 b0=*reinterpret_cast<const bf16x8*>(kb+d0*2048);
    const bf16x8 b1=*reinterpret_cast<const bf16x8*>(kb+d0*2048+512);
    if(d0==0){p0=__builtin_amdgcn_mfma_f32_32x32x16_bf16(b0,qr[0],negm,0,0,0);p1=__builtin_amdgcn_mfma_f32_32x32x16_bf16(b1,qr[0],negm,0,0,0);}
    else{p0=__builtin_amdgcn_mfma_f32_32x32x16_bf16(b0,qr[d0],p0,0,0,0);p1=__builtin_amdgcn_mfma_f32_32x32x16_bf16(b1,qr[d0],p1,0,0,0);}}
}
typedef __attribute__((address_space(3))) const char* lds_cptr;
typedef short v4i16_t __attribute__((ext_vector_type(4)));
__device__ __forceinline__ void kload8(bf16x8*kf,lds_cptr kp){
  kf[0]=*(const __attribute__((address_space(3))) bf16x8*)(kp);      kf[1]=*(const __attribute__((address_space(3))) bf16x8*)(kp+512);
  kf[2]=*(const __attribute__((address_space(3))) bf16x8*)(kp+2048); kf[3]=*(const __attribute__((address_space(3))) bf16x8*)(kp+2560);
  kf[4]=*(const __attribute__((address_space(3))) bf16x8*)(kp+4096); kf[5]=*(const __attribute__((address_space(3))) bf16x8*)(kp+4608);
  kf[6]=*(const __attribute__((address_space(3))) bf16x8*)(kp+6144); kf[7]=*(const __attribute__((address_space(3))) bf16x8*)(kp+6656);
}
__device__ __forceinline__ void kload2(bf16x8*kf,lds_cptr kp,int j){ kf[2*j]=*(const __attribute__((address_space(3))) bf16x8*)(kp+j*2048); kf[2*j+1]=*(const __attribute__((address_space(3))) bf16x8*)(kp+j*2048+512); }
__device__ __forceinline__ s16x4 vtr(lds_cptr p){ return __builtin_bit_cast(s16x4,__builtin_amdgcn_ds_read_tr16_b64_v4i16((__attribute__((address_space(3))) v4i16_t*)p)); }
__device__ __forceinline__ float rowmax(const f32x16&p0,const f32x16&p1){
  float a=max3f(p0[0],p0[1],p1[0]),b=max3f(p0[2],p0[3],p1[1]);a=max3f(a,p1[2],p1[3]);
  #pragma unroll
  for(int r=4;r<16;r+=4){a=max3f(a,p0[r],p0[r+1]);b=max3f(b,p0[r+2],p0[r+3]);a=max3f(a,p1[r],p1[r+1]);b=max3f(b,p1[r+2],p1[r+3]);}
  const float m=max2f(a,b);
  auto rr=__builtin_amdgcn_permlane32_swap(__float_as_uint(m),__float_as_uint(m),false,false);
  return max2f(__uint_as_float(rr[0]),__uint_as_float(rr[1]));
}
__device__ __forceinline__ void pv(f32x16*o,int vb,bf16x8 pa0,bf16x8 pa1,bf16x8 pa2,bf16x8 pa3){
  #pragma unroll
  for(int d0=0;d0<2;++d0){s16x4 lo[4],hi[4];
    #pragma unroll
    for(int ks=0;ks<4;++ks){
      asm volatile("ds_read_b64_tr_b16 %0,%1 offset:%c2":"=&v"(lo[ks]):"v"(vb),"i"(d0*4096+ks*1024):"memory");
      asm volatile("ds_read_b64_tr_b16 %0,%1 offset:%c2":"=&v"(hi[ks]):"v"(vb),"i"(d0*4096+ks*1024+512):"memory");}
    asm volatile("s_waitcnt lgkmcnt(0)":::"memory");SBAR();
    #define PK(k) (bf16x8){lo[k][0],lo[k][1],lo[k][2],lo[k][3],hi[k][0],hi[k][1],hi[k][2],hi[k][3]}
    o[d0]=__builtin_amdgcn_mfma_f32_32x32x16_bf16(pa0,PK(0),o[d0],0,0,0);
    o[d0]=__builtin_amdgcn_mfma_f32_32x32x16_bf16(pa1,PK(1),o[d0],0,0,0);
    o[d0]=__builtin_amdgcn_mfma_f32_32x32x16_bf16(pa2,PK(2),o[d0],0,0,0);
    o[d0]=__builtin_amdgcn_mfma_f32_32x32x16_bf16(pa3,PK(3),o[d0],0,0,0);
    #undef PK
  }
}

__device__ __forceinline__ void attn_stream_issue(const bf16*__restrict__ Kh,const bf16*__restrict__ Vh,int t_lo,int nT,char*shm,int lane_in){
  const int lane=lane_in; const int wid=__builtin_amdgcn_readfirstlane((int)threadIdx.x>>6);
  const unsigned lds0=(unsigned)(uintptr_t)shm;
  const bf16*ksrc=Kh+(long)lane*PITCH+wid*8;
  const bf16*vsrc=Vh+(long)(16*(wid&3)+(lane>>2))*PITCH+(wid>>2)*32+(lane&3)*8;
  const unsigned kdst=lds0+LDS_K+wid*1024, vdst=lds0+LDS_V+wid*1024;
  #define TACT(t) (t_lo+((t)<nT?(t):nT-1))
  glds16(ksrc+(long)TACT(0)*KVBLK*PITCH,(unsigned)__builtin_amdgcn_readfirstlane(kdst));
  glds16(vsrc+(long)TACT(0)*KVBLK*PITCH,(unsigned)__builtin_amdgcn_readfirstlane(vdst));
  glds16(ksrc+(long)TACT(1)*KVBLK*PITCH,(unsigned)__builtin_amdgcn_readfirstlane(kdst+SLOTB));
  glds16(ksrc+(long)TACT(2)*KVBLK*PITCH,(unsigned)__builtin_amdgcn_readfirstlane(kdst+2*SLOTB));
  #undef TACT
}
template<int THRL,class Mask,bool PRE_ISSUED=false> __device__ __forceinline__ void attn_stream(const bf16*__restrict__ Kh,const bf16*__restrict__ Vh,int t_lo,int nT,const bf16x8*qr,const Mask&mask,char*shm,f32x16*o,float&l_out,int lane_in){
  const int lane=lane_in,r32=lane&31,hi=lane>>5; const int wid=__builtin_amdgcn_readfirstlane((int)threadIdx.x>>6);
  const unsigned lds0=(unsigned)(uintptr_t)shm;
  float*wsf=(float*)(shm+LDS_WS)+wid*64;
  const bf16*ksrc=Kh+(long)lane*PITCH+wid*8;
  const bf16*vsrc=Vh+(long)(16*(wid&3)+(lane>>2))*PITCH+(wid>>2)*32+(lane&3)*8;
  const unsigned kdst=lds0+LDS_K+wid*1024, vdst=lds0+LDS_V+wid*1024;
  #define TACT(t) (t_lo+((t)<nT?(t):nT-1))
  #define DMA_K(t,slot) glds16(ksrc+(long)TACT(t)*KVBLK*PITCH,(unsigned)__builtin_amdgcn_readfirstlane(kdst+(slot)))
  #define DMA_V(t,slot) glds16(vsrc+(long)TACT(t)*KVBLK*PITCH,(unsigned)__builtin_amdgcn_readfirstlane(vdst+(slot)))
  const int vb0=(int)(lds0+LDS_V)+((lane>>4)&1)*32+(lane&3)*8+(4*hi+((lane&15)>>2))*64;
  const char*Kbase=shm+LDS_K; bf16x8 kf[8];
  const lds_cptr shm3=(lds_cptr)shm; const lds_cptr kp0=shm3+LDS_K+hi*1024+r32*16; const lds_cptr vp0=shm3+LDS_V+((lane>>4)&1)*32+(lane&3)*8+(4*hi+((lane&15)>>2))*64;
  const int NT=nT<=4?4:((nT+1)&~1);
  if(!PRE_ISSUED){DMA_K(0,0);DMA_V(0,0);DMA_K(1,SLOTB);}
  float mhat=0.f,l_reg=0.f;o[0]=f32x16{};o[1]=f32x16{};f32x16 negm=f32x16{};asm volatile("":"+v"(negm));
#ifdef X_NOMASK
  #define CMASK(P0,P1,t) do{}while(0)
#else
  #define CMASK(P0,P1,t) mask(P0,P1,(t),hi)
#endif
  bool resc=false;
  #define START(P0,P1) do{ const float rm=rowmax(P0,P1); resc=false; \
    { const float dl=(rm==-INFINITY)?0.f:rm; mhat=fadd_s(mhat,dl); \
      _Pragma("unroll") for(int r=0;r<16;++r){P0[r]=fsub_s(P0[r],dl);P1[r]=fsub_s(P1[r],dl);} \
      _Pragma("unroll") for(int r=0;r<16;++r)negm[r]=-mhat; asm volatile("":"+v"(negm)); } \
    _Pragma("unroll") for(int r=0;r<16;++r)P0[r]=__builtin_amdgcn_exp2f(P0[r]); }while(0)
  #define RESC() do{ if(resc){ asm volatile("s_waitcnt lgkmcnt(0)":::"memory"); \
      _Pragma("unroll") for(int d_=0;d_<2;++d_) _Pragma("unroll") for(int r=0;r<16;++r)o[d_][r]*=wsf[crow(r,hi)]; } }while(0)
  f32x16 pA0,pA1,pB0,pB1;
  int sl_prev=0,sl_cur=0,sl_next=SLOTB;
  #define ROT() do{sl_prev=sl_cur;sl_cur=sl_next;sl_next=(sl_next==(NSLOT-1)*SLOTB)?0:sl_next+SLOTB;}while(0)
  if(!PRE_ISSUED){DMA_K(2,2*SLOTB);}
  WAIT_BAR(3);
  qkt(pA0,pA1,Kbase,qr,negm,r32,hi);asm volatile("s_nop 15\n\ts_nop 7":"+v"(pA0),"+v"(pA1));CMASK(pA0,pA1,0);
  START(pA0,pA1);
  _Pragma("unroll") for(int r=0;r<16;++r)pA1[r]=__builtin_amdgcn_exp2f(pA1[r]);
  WAIT_BAR(0);
  DMA_K(3,0);DMA_V(1,SLOTB);
  ROT();
  kload8(kf,kp0+sl_cur);
  WAIT_BAR(2);
  s16x4 vlo[8],vhi[8]; u32x4 pw0,pw1,pw2,pw3;
  #define PKW(P,B) cvtpk_s(P[B],P[B+1])
  #define PAF(k) __builtin_bit_cast(bf16x8,pw##k)
  #define VFR(i) (bf16x8){vlo[i][0],vlo[i][1],vlo[i][2],vlo[i][3],vhi[i][0],vhi[i][1],vhi[i][2],vhi[i][3]}
  #define PIN(x) asm volatile("":"+v"(x))
  #define MX3(a,b,c) __builtin_fmaxf(__builtin_fmaxf((a),(b)),(c))
  #define GAPA(MF,A0,A1,A2,A3,W0,W1,PW) do{ MF; sacc+=A0; sacc+=A1; sacc+=A2; sacc+=A3; PIN(sacc); W0; W1; PIN(PW); SBAR(); }while(0)
  #define EX(v) __builtin_amdgcn_exp2f(v)
  #define GAPB(MF,X,B) do{ MF; X[B]=EX(X[B]); X[B+1]=EX(X[B+1]); X[B+2]=EX(X[B+2]); X[B+3]=EX(X[B+3]); PIN(X); SBAR(); }while(0)
  #define VRD(i) do{ vlo[i]=vtr(vp_+(((i)>>2)*4096+((i)&3)*1024)); vhi[i]=vtr(vp_+(((i)>>2)*4096+((i)&3)*1024+512)); }while(0)
  #define KRD(G,j) do{ if(G){ kload2(kf,kp0+sl_next,j); SBAR(); } }while(0)
  #define STEP(C0,C1,P0,P1,t,GK,GV,GL) do{ SBAR(); \
    const lds_cptr vp_=vp0+sl_prev; \
    VRD(0); SBAR(); float sacc=(P0[0]+P0[1]); \
    GAPA(C0=__builtin_amdgcn_mfma_f32_32x32x16_bf16(kf[0],qr[0],negm,0,0,0), P0[2],P0[3],P0[4],P0[5],     pw0[0]=PKW(P0,0), pw0[1]=PKW(P0,2), pw0); \
    VRD(4); SBAR(); GAPA(C1=__builtin_amdgcn_mfma_f32_32x32x16_bf16(kf[1],qr[0],negm,0,0,0), P0[6],P0[7],P0[8],P0[9],     pw0[2]=PKW(P0,4), pw0[3]=PKW(P0,6), pw0); \
    VRD(1); SBAR(); GAPA(C0=__builtin_amdgcn_mfma_f32_32x32x16_bf16(kf[2],qr[1],C0,0,0,0),   P0[10],P0[11],P0[12],P0[13], pw1[0]=PKW(P0,8), pw1[1]=PKW(P0,10), pw1); \
    VRD(5); SBAR(); GAPA(C1=__builtin_amdgcn_mfma_f32_32x32x16_bf16(kf[3],qr[1],C1,0,0,0),   P0[14],P0[15],P1[0],P1[1],   pw1[2]=PKW(P0,12),pw1[3]=PKW(P0,14), pw1); \
    VRD(2); SBAR(); GAPA(C0=__builtin_amdgcn_mfma_f32_32x32x16_bf16(kf[4],qr[2],C0,0,0,0),   P1[2],P1[3],P1[4],P1[5],     pw2[0]=PKW(P1,0), pw2[1]=PKW(P1,2), pw2); \
    VRD(6); SBAR(); GAPA(C1=__builtin_amdgcn_mfma_f32_32x32x16_bf16(kf[5],qr[2],C1,0,0,0),   P1[6],P1[7],P1[8],P1[9],     pw2[2]=PKW(P1,4), pw2[3]=PKW(P1,6), pw2); \
    VRD(3); SBAR(); GAPA(C0=__builtin_amdgcn_mfma_f32_32x32x16_bf16(kf[6],qr[3],C0,0,0,0),   P1[10],P1[11],P1[12],P1[13], pw3[0]=PKW(P1,8), pw3[1]=PKW(P1,10), pw3); \
    VRD(7); SBAR(); GAPA(C1=__builtin_amdgcn_mfma_f32_32x32x16_bf16(kf[7],qr[3],C1,0,0,0),   P1[14],P1[15],0.f,0.f,       pw3[2]=PKW(P1,12),pw3[3]=PKW(P1,14), pw3); \
    l_reg+=sacc; \
    if(GK){DMA_K((t)+3,sl_cur);} if(GV){DMA_V((t)+1,sl_next);} \
    CMASK(C0,C1,t); \
    { float a=MX3(C0[0],C0[1],C1[0]),b=MX3(C0[2],C0[3],C1[1]); a=MX3(a,C1[2],C1[3]); \
      _Pragma("unroll") for(int r=4;r<16;r+=4){a=MX3(a,C0[r],C0[r+1]);b=MX3(b,C0[r+2],C0[r+3]);a=MX3(a,C1[r],C1[r+1]);b=MX3(b,C1[r+2],C1[r+3]);} \
      float rm=__builtin_fmaxf(a,b); { auto rr=__builtin_amdgcn_permlane32_swap(__float_as_uint(rm),__float_as_uint(rm),false,false); rm=__builtin_fmaxf(__uint_as_float(rr[0]),__uint_as_float(rr[1])); } \
      resc=false; \
      if(__builtin_expect(__any(rm>(float)THRL),0)){ const float dl=__builtin_fmaxf(rm,0.f); mhat+=dl; \
        _Pragma("unroll") for(int r=0;r<16;++r){C0[r]-=dl;C1[r]-=dl;} \
        _Pragma("unroll") for(int r=0;r<16;++r)negm[r]=-mhat; asm volatile("":"+v"(negm)); \
        const float f=__builtin_amdgcn_exp2f(-dl); l_reg*=f; if(hi==0)wsf[r32]=f; resc=true; } } \
    SBAR(); \
    GAPB(o[0]=__builtin_amdgcn_mfma_f32_32x32x16_bf16(PAF(0),VFR(0),o[0],0,0,0), C0,0); \
    GAPB(o[1]=__builtin_amdgcn_mfma_f32_32x32x16_bf16(PAF(0),VFR(4),o[1],0,0,0), C0,4); \
    KRD(GL,0); GAPB(o[0]=__builtin_amdgcn_mfma_f32_32x32x16_bf16(PAF(1),VFR(1),o[0],0,0,0), C0,8); \
    KRD(GL,1); GAPB(o[1]=__builtin_amdgcn_mfma_f32_32x32x16_bf16(PAF(1),VFR(5),o[1],0,0,0), C0,12); \
    KRD(GL,2); GAPB(o[0]=__builtin_amdgcn_mfma_f32_32x32x16_bf16(PAF(2),VFR(2),o[0],0,0,0), C1,0); \
    KRD(GL,3); GAPB(o[1]=__builtin_amdgcn_mfma_f32_32x32x16_bf16(PAF(2),VFR(6),o[1],0,0,0), C1,4); \
    GAPB(o[0]=__builtin_amdgcn_mfma_f32_32x32x16_bf16(PAF(3),VFR(3),o[0],0,0,0), C1,8); \
    GAPB(o[1]=__builtin_amdgcn_mfma_f32_32x32x16_bf16(PAF(3),VFR(7),o[1],0,0,0), C1,12); \
    }while(0)
  int t=1;
  for(;t+5<NT;t+=2){
    STEP(pB0,pB1,pA0,pA1,t,true,true,true);     WAIT_BAR(2); RESC(); ROT();
    STEP(pA0,pA1,pB0,pB1,t+1,true,true,true);   WAIT_BAR(2); RESC(); ROT();
  }
  #define ENDW(tt) do{ if((tt)+3<NT){WAIT_BAR(2);} else if((tt)+2<NT){WAIT_BAR(1);} else {WAIT_BAR(0);} }while(0)
  for(;t+1<NT;t+=2){
    STEP(pB0,pB1,pA0,pA1,t,(t+3<NT),(t+1<NT),(t+1<NT));       ENDW(t);   RESC(); ROT();
    STEP(pA0,pA1,pB0,pB1,t+1,(t+4<NT),(t+2<NT),(t+2<NT));     ENDW(t+1); RESC(); ROT();
  }
  STEP(pB0,pB1,pA0,pA1,NT-1,false,false,false); RESC();
  { float sacc=pB0[0]+pB0[1]; _Pragma("unroll") for(int r=2;r<16;++r)sacc+=pB0[r]; _Pragma("unroll") for(int r=0;r<16;++r)sacc+=pB1[r]; l_reg+=sacc;
    pw0=(u32x4){PKW(pB0,0),PKW(pB0,2),PKW(pB0,4),PKW(pB0,6)};pw1=(u32x4){PKW(pB0,8),PKW(pB0,10),PKW(pB0,12),PKW(pB0,14)};pw2=(u32x4){PKW(pB1,0),PKW(pB1,2),PKW(pB1,4),PKW(pB1,6)};pw3=(u32x4){PKW(pB1,8),PKW(pB1,10),PKW(pB1,12),PKW(pB1,14)};
    SBAR(); pv(o,vb0+sl_cur,PAF(0),PAF(1),PAF(2),PAF(3)); }
  #undef PKW
  #undef PAF
  #undef VFR
  #undef PIN
  #undef MX3
  #undef GAPA
  #undef GAPB
  #undef EX
  #undef VRD
  #undef KRD
  #undef STEP
  #undef ENDW
  {auto rr=__builtin_amdgcn_permlane32_swap(__float_as_uint(l_reg),__float_as_uint(l_reg),false,false);l_reg=__uint_as_float(rr[0])+__uint_as_float(rr[1]);}
  l_out=l_reg;
  asm volatile("s_waitcnt lgkmcnt(0)\n\ts_barrier":::"memory");
  #undef DMA_K
  #undef TACT
  #undef DMA_V
  #undef CMASK
  #undef START
  #undef RESC
  #undef ROT
}

#undef WAIT_BAR
}
template <bool FRAG = false>
__device__ __forceinline__ void p0_transpose_item(const float* W, int K, int ldw, int nsrc, bf16* WT, int drow0, int scol0, int k0, LAS float* scr, int lane, const float* gk = nullptr) {
    const int sc = scol0 + (lane & 31); const bool ok = sc < nsrc;
    float tv[32];
#pragma unroll
    for (int i = 0; i < 32; ++i) { const int kk = 2 * i + (lane >> 5); tv[i] = ok ? __builtin_nontemporal_load(W + (size_t)(k0 + kk) * ldw + sc) : 0.f; if (gk) tv[i] *= gk[k0 + kk]; }
#pragma unroll
    for (int i = 0; i < 32; ++i) { const int kk = 2 * i + (lane >> 5); scr[kk * 33 + (lane & 31)] = tv[i]; }
    LDS_WAIT(); asm volatile("" ::: "memory");
    const int c = lane & 7;
#pragma unroll
    for (int j = 0; j < 4; ++j) { const int n = (lane >> 3) + 8 * j; const LAS float* s = scr + (8 * c) * 33 + n;
        v4u o; o.x = pk2(s[0 * 33], s[1 * 33]); o.y = pk2(s[2 * 33], s[3 * 33]); o.z = pk2(s[4 * 33], s[5 * 33]); o.w = pk2(s[6 * 33], s[7 * 33]);
        if (FRAG) { const int row = drow0 + n, k = k0 + 8 * c; *(GAS v4u*)(WT + ((size_t)((row >> 5) * 128 + (k >> 4)) * 64 + ((k >> 3) & 1) * 32 + (row & 31)) * 8) = o; }
        else *(GAS v4u*)(WT + (size_t)(drow0 + n) * K + k0 + 8 * c) = o; }
    LDS_WAIT(); asm volatile("" ::: "memory");
}
template <bool TILEPERM, bool FRAG = false>
__device__ __forceinline__ void p0_plain(const float* W, int K, int nsrc, int ndest, bf16* WT, int item, LAS float* scr, int lane, const float* gk = nullptr) {
    const int nblk = ndest / 32, kb = item / nblk, nb = item % nblk, n0 = 32 * nb;
    const int scol0 = TILEPERM ? (n0 & ~255) + 64 * ((n0 >> 5) & 3) + 32 * ((n0 >> 7) & 1) : n0;
    p0_transpose_item<FRAG>(W, K, nsrc, nsrc, WT, n0, scol0, 64 * kb, scr, lane, gk);
}
template <int NR>
__device__ __forceinline__ void rms_rows_to_bf16(const float* x, const float* g, bf16* o, int m0, int rstride, int mlim, int lane, float* rs = nullptr) {
    f32x4 v[NR][4];
#pragma unroll
    for (int r = 0; r < NR; ++r) { const int m = m0 + r * rstride; const GAS f32x4* xr = (const GAS f32x4*)(x + (size_t)(m < mlim ? m : m0) * DM) + lane;
#pragma unroll
        for (int j = 0; j < 4; ++j) v[r][j] = __builtin_nontemporal_load(xr + 64 * j); }
    f32x4 gg[4];
#pragma unroll
    for (int j = 0; j < 4; ++j) gg[j] = g ? ((const GAS f32x4*)g + lane)[64 * j] : (f32x4){1.f, 1.f, 1.f, 1.f};
#pragma unroll
    for (int r = 0; r < NR; ++r) { const int m = m0 + r * rstride; float s2 = 0.f;
#pragma unroll
        for (int j = 0; j < 4; ++j) s2 += (v[r][j].x * v[r][j].x + v[r][j].y * v[r][j].y) + (v[r][j].z * v[r][j].z + v[r][j].w * v[r][j].w);
        const float rstd = 1.0f / sqrtf(wave_sum(s2) * (1.f / DM) + EPS);
        if (m < mlim) { GAS unsigned long long* o8 = (GAS unsigned long long*)(o + (size_t)m * DM) + lane;
#pragma unroll
            for (int j = 0; j < 4; ++j) { const f32x4 y = v[r][j] * rstd * gg[j]; o8[64 * j] = (unsigned long long)pk2(y.x, y.y) | ((unsigned long long)pk2(y.z, y.w) << 32); }
            if (rs && lane == 0) rs[m] = rstd; } }
}
__device__ __forceinline__ void p0_prologue(Frame& F, const Args& A) {
    LAS float* scr = (LAS float*)(F.lds + RING_OFF + F.wave * 16384);
    const int gw = F.vcu * NWAVES + F.wave, NGW = F.G * NWAVES, lane = F.lane;
    constexpr int I_IN = 16 * (NPROJ / 32), I_W1 = 32 * 8, I_W2 = 4 * 2, I_SQ = 16 * 32, I_KV = 16 * 64, I_GU = 16 * (2 * DFF / 32), I_D = (DFF / 64) * 32;
    constexpr int NITEMS = I_IN + 2 * I_W1 + 2 * I_W2 + 3 * I_SQ + I_KV + I_GU + I_D;
    for (int it = gw; it < NITEMS; it += NGW) {
        int r = it;
        if (r < I_IN) {
            constexpr int nblk = NPROJ / 32; const int kb = r / nblk, nb = r % nblk, n0 = 32 * nb, T = n0 >> 8, rl = n0 & 255;
            const int scol0 = (T >= 2 && T < 6) ? (rl < 128 ? COL_CG : COL_XIN - 128) + 128 * (T - 2) + rl : (n0 & ~255) + 64 * ((n0 >> 5) & 3) + 32 * ((n0 >> 7) & 1);
            p0_transpose_item(INF(4), DM, W_IN_COLS, W_IN_COLS, WSB(WS_WIN), n0, scol0, 64 * kb, scr, lane, INF(3)); continue; } r -= I_IN;
        if (r < I_W1) { p0_plain<false, true>(INF(7), 2048, 256, 256, WSB(WS_W1KC), r, scr, lane); continue; } r -= I_W1;
        if (r < I_W1) { p0_plain<false, true>(INF(10), 2048, 256, 256, WSB(WS_W1VC), r, scr, lane); continue; } r -= I_W1;
        if (r < I_W2) { p0_plain<false>(INF(8), 256, 64, 64, WSB(WS_W2KC), r, scr, lane); continue; } r -= I_W2;
        if (r < I_W2) { p0_plain<false>(INF(11), 256, 64, 64, WSB(WS_W2VC), r, scr, lane); continue; } r -= I_W2;
        if (r < I_SQ) { p0_plain<true>(INF(14), DM, DM, DM, WSB(WS_WOUT), r, scr, lane); continue; } r -= I_SQ;
        if (r < I_SQ) {
#pragma unroll
            for (int j = 0; j < 2; ++j) { const int dr = 2 * r + j, t = dr & 255, sr = (dr & ~255) + 64 * ((t >> 5) & 3) + 32 * ((t >> 7) & 1) + (t & 31); const float gk = INF(16)[sr];
                const GAS f32x4* wr_ = (const GAS f32x4*)(INF(18) + (size_t)sr * DM) + lane; GAS unsigned long long* o8 = (GAS unsigned long long*)(WSB(WS_WQ) + (size_t)dr * DM) + lane;
#pragma unroll
                for (int q4 = 0; q4 < 4; ++q4) { const f32x4 v = __builtin_nontemporal_load(wr_ + 64 * q4) * gk; o8[64 * q4] = (unsigned long long)pk2(v.x, v.y) | ((unsigned long long)pk2(v.z, v.w) << 32); } }
            continue; } r -= I_SQ;
        if (r < I_SQ) { p0_plain<true>(INF(20), DM, DM, DM, WSB(WS_WO), r, scr, lane); continue; } r -= I_SQ;
        if (r < I_KV) { p0_plain<true>(INF(19), DM, 2 * DM, 2 * DM, WSB(WS_WKV), r, scr, lane); continue; } r -= I_KV;
        if (r < I_GU) {
            constexpr int nblk = 2 * DFF / 32; const int kb = r / nblk, nb = r % nblk, n0 = 32 * nb, pn = n0 >> 8, rl = n0 & 255;
            const int scol0 = rl < 128 ? 128 * pn + rl : DFF + 128 * pn + (rl - 128);
            p0_transpose_item(INF(23), DM, 2 * DFF, 2 * DFF, WSB(WS_WGU), n0, scol0, 64 * kb, scr, lane, INF(22)); continue; } r -= I_GU;
        p0_plain<true>(INF(24), DFF, DM, DM, WSB(WS_WD), r, scr, lane);
    }
    for (int it = gw; it < 512; it += NGW) {
        const int mat = it >> 8, n = it & 255; const float* w1 = mat ? INF(10) : INF(7); const float* pe = mat ? INF(9) : INF(6);
        float s = 0.f;
#pragma unroll
        for (int j = 0; j < 32; ++j) { const int k = 64 * j + lane; s += pe[k] * w1[(size_t)k * 256 + n]; }
        s = wave_sum(s);
        if (lane == 0) ((float*)(A.ws + WS_BIAS))[mat * 256 + n] = s;
    }
    { float* rt_ = (float*)(A.ws + WS_ROPE); const int f = lane & 31; const float inv = powf(10000.0f, -(float)f / 32.0f);
      for (int p = gw * 2 + (lane >> 5); p < MTOK; p += NGW * 2) { const float ang = (float)((const int*)A.in[2])[p] * inv; const float tr = __builtin_amdgcn_fractf(ang * 0.15915494309189535f);
          rt_[(size_t)p * 64 + f] = __builtin_amdgcn_cosf(tr); rt_[(size_t)p * 64 + 32 + f] = __builtin_amdgcn_sinf(tr); } }
    for (int m = gw; m < MTOK; m += 4 * NGW) rms_rows_to_bf16<4>(INF(0), nullptr, WSB(WS_XN), m, NGW, MTOK, lane, (float*)(A.ws + WS_RSTD));
    for (int m = gw; m < MMEM; m += NGW) rms_rows_to_bf16<1>(INF(1), INF(17), WSB(WS_MN), m, NGW, MMEM, lane);
}

__device__ __forceinline__ void p2_rope(Frame& F, const Args& A, int ridx, int nrb) {
    const bool xal = (F.G == 256); const int NGW = xal ? nrb * NWAVES : F.G * NWAVES, gw = xal ? (F.vx * SEQ + ridx * NWAVES + F.wave) : (F.vcu * NWAVES + F.wave), lane = F.lane, f = lane & 31, sh = lane >> 5;
    const int MTOKX = xal ? F.vx * SEQ + SEQ : MTOK;
    const float* tbl = (const float*)(A.ws + WS_ROPE);
    const int c0 = (sh ? COL_KW : COL_KSL) + f;
    for (int tok = gw; tok < MTOKX; tok += 4 * NGW) {
        float cs[4], sn[4], x1[4][2], x2[4][2];
#pragma unroll
        for (int j = 0; j < 4; ++j) { const int tk = tok + j * NGW; if (tk < MTOKX) { cs[j] = tbl[(size_t)tk * 64 + f]; sn[j] = tbl[(size_t)tk * 64 + 32 + f]; const bf16* row = WSB(WS_PROJ) + (size_t)tk * NPROJ + c0;
#pragma unroll
            for (int i = 0; i < 2; ++i) { x1[j][i] = bf2f(row[64 * i]); x2[j][i] = bf2f(row[64 * i + 32]); } } }
#pragma unroll
        for (int j = 0; j < 4; ++j) { const int tk = tok + j * NGW; if (tk < MTOKX) { bf16* row = WSB(WS_PROJ) + (size_t)tk * NPROJ + c0;
#pragma unroll
            for (int i = 0; i < 2; ++i) { row[64 * i] = (bf16)f2bf(x1[j][i] * cs[j] - x2[j][i] * sn[j]); row[64 * i + 32] = (bf16)f2bf(x2[j][i] * cs[j] + x1[j][i] * sn[j]); } } }
    }
}
constexpr int HS_PITCH = 264, CA_RP = 66, CA_CS = 16 * CA_RP + 2  , CA_TOK = 16 * CA_RP, CA_BYTES = 8 * CA_CS * 16;
static_assert(CA_BYTES <= LDSCTL_OFF, "compress LDS image");
__device__ __forceinline__ void compress_unit(Frame& F, const Args& A, int u) {
    const int kv = u & 1, slab = (u >> 1) & 3, bgi = u >> 3, b = bgi >> 1, g = bgi & 1;
    const int lane = F.lane, w = F.wave, tid = F.tid, r32 = lane & 31, hi = lane >> 5;
    const bf16* W1t = kv ? WSB(WS_W1VC) : WSB(WS_W1KC); const bf16* W2t = kv ? WSB(WS_W2VC) : WSB(WS_W2KC);
    lchar* aimg = (lchar*)(F.lds + RING_OFF);
    { const bf16* base = WSB(WS_PROJ) + (size_t)(b * SEQ + 1024 * slab) * NPROJ + (kv ? COL_VC : COL_KC) + g * 64;
      const int chunk = tid & 7;
#pragma unroll
      for (int h = 0; h < 2; ++h) {
          v4u tmp[9];
#pragma unroll
          for (int j = 0; j < 9; ++j) { const int nt_ = (tid >> 3) + 64 * (9 * h + j); const int nn = nt_ < CA_TOK ? nt_ : CA_TOK - 1; const int lp = nn / CA_RP, rp = nn - lp * CA_RP;
              tmp[j] = *(const GAS v4u*)(base + (size_t)(16 * rp + lp) * NPROJ + chunk * 8); }
#pragma unroll
          for (int j = 0; j < 9; ++j) { const int nt_ = (tid >> 3) + 64 * (9 * h + j); if (nt_ < CA_TOK) *(LAS v4u*)(aimg + (chunk * CA_CS + nt_) * 16) = tmp[j]; } } }
    __syncthreads();
    const bf16* wsrc = W1t + ((size_t)(w * 128) * 64 + lane) * 8;
    const lchar* ard = aimg + (hi * CA_CS + r32) * 16;
    f32x16 acc[2]; acc[0] = (f32x16){}; acc[1] = (f32x16){};
#pragma unroll 32
    for (int ks = 0; ks < 128; ++ks) {
        const int l = ks >> 2, d0 = ks & 3; const int off = (2 * d0 * CA_CS + (l & 15) * CA_RP + (l >> 4)) * 16;
        const bf16x8 a0 = *(const LAS bf16x8*)(ard + off), a1 = *(const LAS bf16x8*)(ard + off + 512);
        const bf16x8 bb = *(const GAS bf16x8*)(wsrc + 512 * ks);
        acc[0] = mfma32(a0, bb, acc[0]); acc[1] = mfma32(a1, bb, acc[1]);
    }
    __syncthreads();
    LAS bf16* Hs = (LAS bf16*)(F.lds + RING_OFF);
    { const float bv = ((const float*)(A.ws + WS_BIAS))[kv * 256 + 32 * w + r32];
#pragma unroll
      for (int rb = 0; rb < 2; ++rb)
#pragma unroll
        for (int r = 0; r < 16; ++r) { const float h = pg8::silu_f(acc[rb][r] + bv); Hs[(32 * rb + crow(r, hi)) * HS_PITCH + 32 * w + r32] = (bf16)f2bf(h); } }
    __syncthreads();
    if (w < 2) {
        f32x16 a2[2]; a2[0] = (f32x16){}; a2[1] = (f32x16){};
#pragma unroll
        for (int ks = 0; ks < 16; ++ks) {
            const bf16x8 a = *(const LAS bf16x8*)(Hs + (32 * w + r32) * HS_PITCH + 16 * ks + 8 * hi);
#pragma unroll
            for (int cb = 0; cb < 2; ++cb) { const bf16x8 bb = *(const GAS bf16x8*)(W2t + (size_t)(32 * cb + r32) * 256 + 16 * ks + 8 * hi); a2[cb] = mfma32(a, bb, a2[cb]); }
        }
        bf16* dst = (kv ? WSB(WS_VCMP) : WSB(WS_KCMP)) + (size_t)bgi * 256 * 64;
        const float* tbl = (const float*)(A.ws + WS_ROPE);
#pragma unroll
        for (int r = 0; r < 16; ++r) {
            const int i = 64 * slab + 32 * w + crow(r, hi); float o1 = a2[0][r], o2 = a2[1][r];
            if (kv == 0) { int tp = 16 * i + 31; tp = tp > SEQ - 1 ? SEQ - 1 : tp; const float cs = tbl[(size_t)(b * SEQ + tp) * 64 + r32], sn = tbl[(size_t)(b * SEQ + tp) * 64 + 32 + r32];
                const float x1 = o1, x2 = o2; o1 = x1 * cs - x2 * sn; o2 = x2 * cs + x1 * sn; }
            if (i >= 255) { o1 = 0.f; o2 = 0.f; }
            dst[(size_t)i * 64 + r32] = (bf16)f2bf(o1); dst[(size_t)i * 64 + 32 + r32] = (bf16)f2bf(o2);
        }
    }
    __syncthreads();
}

template <int ND0>
__device__ __forceinline__ void qkt(f32x16& p0, f32x16& p1, const lchar* kslot, const bf16x8* qr, int r32, int hi) {
    const lchar* kb = kslot + hi * 1024 + r32 * 16;
    p0 = (f32x16){}; p1 = (f32x16){};
#pragma unroll
    for (int d0 = 0; d0 < ND0; ++d0) {
        const bf16x8 b0 = *(const LAS bf16x8*)(kb + d0 * 2048), b1 = *(const LAS bf16x8*)(kb + d0 * 2048 + 512);
        p0 = mfma32(b0, qr[d0], p0); p1 = mfma32(b1, qr[d0], p1);
    }
}
template <int NDB>
__device__ __forceinline__ void pv(f32x16* o, unsigned vb, bf16x8 pa0, bf16x8 pa1, bf16x8 pa2, bf16x8 pa3) {
#pragma unroll
    for (int d0 = 0; d0 < NDB; ++d0) { s16x4 lo[4], hi[4];
#pragma unroll
        for (int ks = 0; ks < 4; ++ks) {
            asm volatile("ds_read_b64_tr_b16 %0,%1 offset:%c2" : "=&v"(lo[ks]) : "v"(vb), "i"(d0 * 4096 + ks * 1024) : "memory");
            asm volatile("ds_read_b64_tr_b16 %0,%1 offset:%c2" : "=&v"(hi[ks]) : "v"(vb), "i"(d0 * 4096 + ks * 1024 + 512) : "memory"); }
        asm volatile("s_waitcnt lgkmcnt(0)" ::: "memory"); SBAR();
#define PKV(k) (bf16x8){lo[k][0], lo[k][1], lo[k][2], lo[k][3], hi[k][0], hi[k][1], hi[k][2], hi[k][3]}
        o[d0] = mfma32(pa0, PKV(0), o[d0]);
        o[d0] = mfma32(pa1, PKV(1), o[d0]);
        o[d0] = mfma32(pa2, PKV(2), o[d0]);
        o[d0] = mfma32(pa3, PKV(3), o[d0]);
#undef PKV
    }
}
__device__ __forceinline__ float rowmax32(const f32x16& p0, const f32x16& p1) {
    float a = fmaxf(p0[0], p1[0]);
#pragma unroll
    for (int r = 1; r < 16; ++r) a = fmaxf(a, fmaxf(p0[r], p1[r]));
    return pair_max(a);
}
__device__ __forceinline__ void mask_range(f32x16& p0, f32x16& p1, int lo, int hi_, int hi) {
#pragma unroll
    for (int r = 0; r < 16; ++r) { const int kv = crow(r, hi);
        if (kv < lo || kv > hi_) p0[r] = -INFINITY;
        if (kv + 32 < lo || kv + 32 > hi_) p1[r] = -INFINITY; }
}
#define PKW(P, B) cvtpk(P[B], P[B + 1])
#define PACK4(P, B) __builtin_bit_cast(bf16x8, (v4u){PKW(P, B), PKW(P, B + 2), PKW(P, B + 4), PKW(P, B + 6)})

struct TileSrc { const bf16* K; const bf16* V; int pitch; };
__device__ __forceinline__ void tile_load(v4u& kr, v4u& vr, const TileSrc& s, int key0, int lane, int w) {
    kr = *(const GAS v4u*)(s.K + (size_t)(key0 + lane) * s.pitch + w * 8);
    vr = *(const GAS v4u*)(s.V + (size_t)(key0 + 16 * (w & 3) + (lane >> 2)) * s.pitch + (w >> 2) * 32 + (lane & 3) * 8);
}
__device__ __forceinline__ void tile_store(lchar* kslot, lchar* vslot, const v4u& kr, const v4u& vr, int lane, int w) {
    *(LAS v4u*)(kslot + w * 1024 + lane * 16) = kr; *(LAS v4u*)(vslot + w * 1024 + lane * 16) = vr;
}

struct Br { f32x16 o[2]; float m, l; };
__device__ __forceinline__ void flash_tile(Br& st, const lchar* kslot, unsigned vb, const bf16x8* qr, bool need_mask, int mlo, int mhi, LAS float* wsf, int r32, int hi) {
    f32x16 p0, p1; qkt<4>(p0, p1, kslot, qr, r32, hi);
    if (need_mask) mask_range(p0, p1, mlo, mhi, hi);
    const float rm = rowmax32(p0, p1);
    if (__any(rm > st.m)) {
        const float mn = fmaxf(st.m, rm); const float al = (mn == -INFINITY) ? 1.0f : __builtin_amdgcn_exp2f(st.m - mn);
        st.l *= al; st.m = mn;
        if (hi == 0) wsf[r32] = al;
        LDS_WAIT(); asm volatile("" ::: "memory");
#pragma unroll
        for (int r = 0; r < 16; ++r) { const float a = wsf[crow(r, hi)]; st.o[0][r] *= a; st.o[1][r] *= a; }
    }
    const float ms = (st.m == -INFINITY) ? 0.f : st.m;
    float s = 0.f;
#pragma unroll
    for (int r = 0; r < 16; ++r) { p0[r] = __builtin_amdgcn_exp2f(p0[r] - ms); p1[r] = __builtin_amdgcn_exp2f(p1[r] - ms); s += p0[r] + p1[r]; }
    st.l += s;
    pv<2>(st.o, vb, PACK4(p0, 0), PACK4(p0, 8), PACK4(p1, 0), PACK4(p1, 8));
}

constexpr int NS_GATE = 117504;
constexpr int NS_YSTG = 51200, NS_IMP = NS_YSTG, NS_CV = NS_IMP + 16896, IMP_P = 65, NS_SELM = NS_YSTG + 65536, NS_RSQ = NS_SELM + 512;
static_assert(ab::LDS_END <= NS_YSTG && NS_RSQ + 256 <= NS_GATE && NS_GATE + 6144 <= RING_BYTES, "NSA LDS map");
__device__ __forceinline__ void mask_gt(f32x16& c0, f32x16& c1, int tl, int hi) {
    int thr = tl - 4 * hi; asm volatile("" : "+v"(thr));
#pragma unroll
    for (int r = 0; r < 16; ++r) { const int c = crow(r, 0); c0[r] = (c > thr) ? -INFINITY : c0[r]; c1[r] = (c + 32 > thr) ? -INFINITY : c1[r]; }
}
__device__ __forceinline__ void mask_le(f32x16& c0, f32x16& c1, int tl, int hi) {
    int thr = tl - 4 * hi; asm volatile("" : "+v"(thr));
#pragma unroll
    for (int r = 0; r < 16; ++r) { const int c = crow(r, 0); c0[r] = (c <= thr) ? -INFINITY : c0[r]; c1[r] = (c + 32 <= thr) ? -INFINITY : c1[r]; }
}
struct MaskSlc { unsigned long long sel; int nT, qt, tl;
    __device__ __forceinline__ void operator()(f32x16& c0, f32x16& c1, int j, int hi) const {
        const bool off = (j >= nT) || (((sel >> j) & 1ull) == 0ull);
        if (__any(off)) {
#pragma unroll
            for (int r = 0; r < 16; ++r) { c0[r] = off ? -INFINITY : c0[r]; c1[r] = off ? -INFINITY : c1[r]; }
        }
#if defined(PROBE_DUP) && PROBE_DUP == 13
        asm volatile("" : "+v"(c0), "+v"(c1));
        if (__any(off)) {
#pragma unroll
            for (int r = 0; r < 16; ++r) { c0[r] = off ? -INFINITY : c0[r]; c1[r] = off ? -INFINITY : c1[r]; }
        }
#endif
        if (j == qt) mask_gt(c0, c1, tl, hi);
    }
};
struct MaskWin { int nT, qt, tl, t_lo;
    __device__ __forceinline__ void operator()(f32x16& c0, f32x16& c1, int j, int hi) const {
        const int T = t_lo + j; const bool pad = j >= nT;
        if (pad || T == qt || T == qt - 8) {
            int up = (pad ? -1 : (T == qt ? tl : 1000)) - 4 * hi, lo = (T == qt - 8 ? tl : -1000) - 4 * hi; asm volatile("" : "+v"(up), "+v"(lo));
#pragma unroll
            for (int r = 0; r < 16; ++r) { const int c = crow(r, 0); c0[r] = (c > up || c <= lo) ? -INFINITY : c0[r]; c1[r] = (c + 32 > up || c + 32 <= lo) ? -INFINITY : c1[r]; }
        }
    }
};
__device__ __forceinline__ void nsa_unit(Frame& F, const Args& A, int b, int qt) {
    const int w = F.wave, tid = F.tid;
#define FRESH_LANE() int lane = F.lane; asm volatile("" : "+v"(lane)); const int r32 = lane & 31, hi = lane >> 5; (void)r32; (void)hi
#define LANE_VARS() const int qi = r32 & 7, hd = r32 >> 3, tl = 8 * w + qi; const size_t mytok = tok0 + 64 * qt + tl; (void)hd; (void)mytok
    lchar* ring = (lchar*)(F.lds + RING_OFF);
    char* shm = (char*)(F.lds + RING_OFF);
    LAS float* wsf = (LAS float*)(ring + ab::LDS_WS) + w * 64;
    LAS float* IMP = (LAS float*)(ring + NS_IMP);
    LAS unsigned long long* SELM = (LAS unsigned long long*)(ring + NS_SELM);
    LAS float* RSQ = (LAS float*)(ring + NS_RSQ);
    LAS float* ystg = (LAS float*)(ring + NS_YSTG) + w * 2048;
#define VLANE() ((unsigned)(((lane >> 4) & 1) * 32 + (lane & 3) * 8 + (4 * hi + ((lane & 15) >> 2)) * 64))
    const unsigned ring_addr = (unsigned)(uintptr_t)ring;
    const size_t tok0 = (size_t)b * SEQ;
    if (tid < 64) RSQ[tid] = 0.f;

#pragma nounroll
    for (int g = 0; g < 2; ++g) {
        bf16x8 qr[4];
#if defined(PROBE_DUP) && PROBE_DUP == 8
        for (int rep_ = 0; rep_ < 2; ++rep_)
#endif
#define GATE(k) (((LAS float*)(ring + NS_GATE))[(k) * 512 + tid])
        { FRESH_LANE(); LANE_VARS();
        { const bf16* qp = WSB(WS_PROJ) + mytok * NPROJ + COL_Q + (g * 4 + hd) * 64 + 8 * hi;
          v4u raw[4];
#pragma unroll
          for (int d0 = 0; d0 < 4; ++d0) raw[d0] = __builtin_nontemporal_load((const GAS v4u*)(qp + 16 * d0));
          const float* tb = (const float*)(A.ws + WS_ROPE) + mytok * 64 + 8 * hi;
#pragma unroll
          for (int dl = 0; dl < 2; ++dl) {
              const f32x4 c0 = *(const GAS f32x4*)(tb + 16 * dl), c1 = *(const GAS f32x4*)(tb + 16 * dl + 4), s0 = *(const GAS f32x4*)(tb + 32 + 16 * dl), s1 = *(const GAS f32x4*)(tb + 32 + 16 * dl + 4);
              const float cs[8] = {c0.x, c0.y, c0.z, c0.w, c1.x, c1.y, c1.z, c1.w}, sn[8] = {s0.x, s0.y, s0.z, s0.w, s1.x, s1.y, s1.z, s1.w};
              const v4u a = raw[dl], bq = raw[dl + 2];
              const float x1[8] = {bflo(a.x), bfhi(a.x), bflo(a.y), bfhi(a.y), bflo(a.z), bfhi(a.z), bflo(a.w), bfhi(a.w)};
              const float x2[8] = {bflo(bq.x), bfhi(bq.x), bflo(bq.y), bfhi(bq.y), bflo(bq.z), bfhi(bq.z), bflo(bq.w), bfhi(bq.w)};
              float o1[8], o2[8];
#pragma unroll
              for (int j = 0; j < 8; ++j) { o1[j] = (x1[j] * cs[j] - x2[j] * sn[j]) * C2_NSA; o2[j] = (x2[j] * cs[j] + x1[j] * sn[j]) * C2_NSA; }
              qr[dl] = __builtin_bit_cast(bf16x8, (v4u){cvtpk(o1[0], o1[1]), cvtpk(o1[2], o1[3]), cvtpk(o1[4], o1[5]), cvtpk(o1[6], o1[7])});
              qr[dl + 2] = __builtin_bit_cast(bf16x8, (v4u){cvtpk(o2[0], o2[1]), cvtpk(o2[2], o2[3]), cvtpk(o2[4], o2[5]), cvtpk(o2[6], o2[7])});
          } }
        { const bf16* gp = WSB(WS_PROJ) + mytok * NPROJ + COL_GL + (g * 4 + hd) * 3;
#pragma unroll
          for (int k = 0; k < 3; ++k) GATE(k) = __builtin_amdgcn_rcpf(1.0f + __builtin_amdgcn_exp2f(-LOG2E * bf2f(gp[k]))); }
        }
        const int ntc = ((4 * qt + 2) >> 6) + 1;
        f32x16 y[2];
#if defined(PROBE_DUP) && PROBE_DUP == 7
        for (int rep_ = 0; rep_ < 2; ++rep_) {
        if (rep_) __syncthreads();
#else
        {
#endif
        y[0] = (f32x16){}; y[1] = (f32x16){};

#ifndef X_NOCMP
        { FRESH_LANE(); LANE_VARS(); const unsigned vlane = VLANE();
            const int imax = (64 * qt + tl - 31) >> 4;
            const int imax_w = (64 * qt + 8 * w - 31) >> 4;
            const bf16* Kc = WSB(WS_KCMP) + (size_t)(b * 2 + g) * 256 * 64; const bf16* Vc = WSB(WS_VCMP) + (size_t)(b * 2 + g) * 256 * 64;
            { v4u kr4[4], vr4[4];
#pragma unroll
              for (int T = 0; T < 4; ++T) { const int Tc = T < ntc ? T : 0;
                  kr4[T] = *(const GAS v4u*)(Kc + (size_t)(64 * Tc + lane) * 64 + w * 8);
                  vr4[T] = *(const GAS v4u*)(Vc + (size_t)(64 * Tc + 16 * (w & 3) + (lane >> 2)) * 64 + (w >> 2) * 32 + (lane & 3) * 8); }
#pragma unroll
              for (int T = 0; T < 4; ++T) if (T < ntc) { *(LAS v4u*)(ring + T * 8192 + w * 1024 + lane * 16) = kr4[T]; *(LAS v4u*)(ring + NS_CV + T * 8192 + w * 1024 + lane * 16) = vr4[T]; } }
            __syncthreads();
            float m = -INFINITY, l = 0.f;
#pragma nounroll
            for (int T = 0; T < ntc; ++T) {
                f32x16 p0, p1; qkt<4>(p0, p1, ring + T * 8192, qr, r32, hi); if (64 * T + 63 > imax_w) mask_gt(p0, p1, imax - 64 * T, hi);
                const float rm = rowmax32(p0, p1), mn = fmaxf(m, rm);
                const float al = (mn == -INFINITY) ? 1.0f : __builtin_amdgcn_exp2f(m - mn); l *= al; m = mn;
                const float msa = (mn == -INFINITY) ? 0.f : mn; float sm = 0.f;
#pragma unroll
                for (int r = 0; r < 16; ++r) sm += __builtin_amdgcn_exp2f(p0[r] - msa) + __builtin_amdgcn_exp2f(p1[r] - msa);
                l += sm;
            }
            l = pair_sum(l);
            const float ms = (m == -INFINITY) ? 0.f : m, inv_l = l > 0.f ? 1.0f / l : 0.f, g0 = GATE(0);
            float carry = 0.f;
#pragma nounroll
            for (int T = 0; T < ntc; ++T) {
                f32x16 p0, p1; qkt<4>(p0, p1, ring + T * 8192, qr, r32, hi); if (64 * T + 63 > imax_w) mask_gt(p0, p1, imax - 64 * T, hi);
#pragma unroll
                for (int r = 0; r < 16; ++r) { p0[r] = __builtin_amdgcn_exp2f(p0[r] - ms) * inv_l; p1[r] = __builtin_amdgcn_exp2f(p1[r] - ms) * inv_l; }
                { float ia[8], ic[8];
#pragma unroll
                  for (int rq = 0; rq < 4; ++rq) { ic[rq] = 0.5f * p0[4 * rq + 3]; ia[rq] = (p0[4 * rq] + p0[4 * rq + 1]) + (p0[4 * rq + 2] + ic[rq]);
                      ic[4 + rq] = 0.5f * p1[4 * rq + 3]; ia[4 + rq] = (p1[4 * rq] + p1[4 * rq + 1]) + (p1[4 * rq + 2] + ic[4 + rq]); }
#pragma unroll
                  for (int i = 0; i < 8; ++i) { ia[i] += __shfl_xor(ia[i], 8); ia[i] += __shfl_xor(ia[i], 16); ic[i] += __shfl_xor(ic[i], 8); ic[i] += __shfl_xor(ic[i], 16); }
                  float cp[8];
#pragma unroll
                  for (int i = 0; i < 8; ++i) cp[i] = __shfl_xor(ic[i], 32);
                  LAS float* imq = IMP + tl * IMP_P + 16 * T + hi;
#pragma unroll
                  for (int i = 0; i < 8; ++i) { const float prev = hi ? cp[i] : (i > 0 ? cp[i - 1] : carry); const float v = ia[i] + prev; if (hd == 0) imq[8 * (i >> 2) + 2 * (i & 3)] = v; }
                  carry = cp[7]; }
#pragma unroll
                for (int r = 0; r < 16; ++r) { p0[r] *= g0; p1[r] *= g0; }
                pv<2>(y, ring_addr + NS_CV + T * 8192 + vlane, PACK4(p0, 0), PACK4(p0, 8), PACK4(p1, 0), PACK4(p1, 8));
            }
        }
#endif
        }
        __syncthreads();
#ifndef X_NOTOPK
        { FRESH_LANE();
            const bool forced = (lane == 0) || (lane == qt) || (lane == qt - 1); const bool future = lane > qt;
#if defined(PROBE_DUP) && PROBE_DUP == 3
            for (int rep_ = 0; rep_ < 2; ++rep_)
#endif
#pragma nounroll
            for (int k8 = 0; k8 < 8; ++k8) {
                const unsigned vb_ = __float_as_uint(IMP[(8 * w + k8) * IMP_P + lane]);
                const unsigned key = (forced ? 0x7f000000u : (future ? 0u : ((vb_ & ~63u) + 64u))) | (unsigned)(63 - lane);
                int rank = 0;
                ((LAS unsigned*)wsf)[lane] = key; LDS_WAIT(); asm volatile("" ::: "memory");
#pragma unroll
                for (int k4 = 0; k4 < 16; ++k4) if (4 * k4 <= qt) { const v4u k4v = ((const LAS v4u*)wsf)[k4];
                    rank += (int)(k4v.x > key) + (int)(k4v.y > key) + (int)(k4v.z > key) + (int)(k4v.w > key); }
                asm volatile("" ::: "memory");
                const unsigned long long mk = __ballot(rank < 16);
                if (lane == 0) SELM[8 * w + k8] = mk;
            }
        }
#endif
        __syncthreads();
        unsigned long long mysel;
        { FRESH_LANE(); LANE_VARS(); mysel = SELM[tl];
        { LAS float* ysb = ystg + 256 * hi + r32; asm volatile("" : "+v"(ysb));
#pragma unroll
          for (int r = 0; r < 16; ++r) { ysb[crow(r, 0) * 64] = y[0][r]; ysb[crow(r, 0) * 64 + 32] = y[1][r]; } } }

        {
            f32x16 o[2]; float l;
#if !defined(X_NOSLC)
            { FRESH_LANE(); LANE_VARS(); const MaskSlc mk{mysel, qt + 1, qt, tl};
              ab::attn_stream<8, MaskSlc>((const ab::bf16*)(WSB(WS_PROJ) + tok0 * NPROJ + COL_KSL + g * 64), (const ab::bf16*)(WSB(WS_PROJ) + tok0 * NPROJ + COL_VSL + g * 64), 0, qt + 1, qr, mk, shm, o, l, lane); }
            { FRESH_LANE(); LANE_VARS(); const float fsc = l > 0.f ? GATE(1) / l : 0.f;
              if (hi == 0) wsf[r32] = fsc;
              LDS_WAIT(); asm volatile("" ::: "memory");
              LAS float* ysb = ystg + 256 * hi + r32; asm volatile("" : "+v"(ysb)); LAS float* wsh = wsf + 4 * hi; asm volatile("" : "+v"(wsh));
#pragma unroll
              for (int r = 0; r < 16; ++r) { const float a = wsh[crow(r, 0)]; ysb[crow(r, 0) * 64] += a * o[0][r]; ysb[crow(r, 0) * 64 + 32] += a * o[1][r]; } }
#endif
#if !defined(X_NOWIN)
            { FRESH_LANE(); LANE_VARS(); const int t_lo = qt >= 8 ? qt - 8 : 0; const MaskWin mk{qt - t_lo + 1, qt, tl, t_lo};
              ab::attn_stream<8, MaskWin>((const ab::bf16*)(WSB(WS_PROJ) + tok0 * NPROJ + COL_KW + g * 64), (const ab::bf16*)(WSB(WS_PROJ) + tok0 * NPROJ + COL_VW + g * 64), t_lo, qt - t_lo + 1, qr, mk, shm, o, l, lane); }
            { FRESH_LANE(); LANE_VARS(); const float fsc = l > 0.f ? GATE(2) / l : 0.f;
              if (hi == 0) wsf[r32] = fsc;
              LDS_WAIT(); asm volatile("" ::: "memory");
              LAS float* ysb = ystg + 256 * hi + r32; asm volatile("" : "+v"(ysb)); LAS float* wsh = wsf + 4 * hi; asm volatile("" : "+v"(wsh));
#pragma unroll
              for (int r = 0; r < 16; ++r) { const float a = wsh[crow(r, 0)]; ysb[crow(r, 0) * 64] += a * o[0][r]; ysb[crow(r, 0) * 64 + 32] += a * o[1][r]; } }
#endif
        }
        LDS_WAIT(); asm volatile("" ::: "memory");
        { FRESH_LANE(); float pa = 0.f, pb = 0.f;
#pragma unroll
          for (int i = 0; i < 8; ++i) { const int c = lane + 64 * i, row = c >> 4, c16 = c & 15;
              const f32x4 v = *(const LAS f32x4*)(ystg + row * 64 + 4 * c16);
              const float sq = (v.x * v.x + v.y * v.y) + (v.z * v.z + v.w * v.w); if (i & 1) pb += sq; else pa += sq;
              const unsigned long long pk = (unsigned long long)cvtpk(v.x, v.y) | ((unsigned long long)cvtpk(v.z, v.w) << 32);
              *(GAS unsigned long long*)(WSB(WS_MIXED) + (tok0 + 64 * qt + 8 * w + (row & 7)) * DM + 512 + (g * 4 + (row >> 3)) * 64 + 4 * c16) = pk; }
          __hip_atomic_fetch_add(RSQ + 8 * w + (lane >> 4), pa, __ATOMIC_RELAXED, __HIP_MEMORY_SCOPE_WORKGROUP);
          __hip_atomic_fetch_add(RSQ + 8 * w + 4 + (lane >> 4), pb, __ATOMIC_RELAXED, __HIP_MEMORY_SCOPE_WORKGROUP); }
        asm volatile("s_waitcnt vmcnt(0)" ::: "memory");
        __syncthreads();
    }
#ifndef X_NOFINAL
    { FRESH_LANE();
      { bf16* yp = WSB(WS_MIXED) + (tok0 + 64 * qt + 8 * w) * DM + 512 + 8 * lane;
        v4u yv[8];
#pragma unroll
        for (int k8 = 0; k8 < 8; ++k8) yv[k8] = *(const GAS v4u*)(yp + (size_t)k8 * DM);
        const f32x4 g0 = *(const GAS f32x4*)(INF(13) + 8 * lane), g1 = *(const GAS f32x4*)(INF(13) + 8 * lane + 4);
#pragma unroll
        for (int k8 = 0; k8 < 8; ++k8) {
            const float rstd = 1.0f / sqrtf(RSQ[8 * w + k8] * (1.f / 512.f) + EPS); const v4u y4 = yv[k8];
            v4u o; o.x = pk2(bflo(y4.x) * rstd * g0.x, bfhi(y4.x) * rstd * g0.y); o.y = pk2(bflo(y4.y) * rstd * g0.z, bfhi(y4.y) * rstd * g0.w);
            o.z = pk2(bflo(y4.z) * rstd * g1.x, bfhi(y4.z) * rstd * g1.y); o.w = pk2(bflo(y4.w) * rstd * g1.z, bfhi(y4.w) * rstd * g1.w);
            *(GAS v4u*)(yp + (size_t)k8 * DM) = o; } }
      { float cw[3][8];
#pragma unroll
        for (int k = 0; k < 3; ++k) { const f32x4 a0 = *(const GAS f32x4*)(INF(5) + k * 512 + 8 * lane), a1 = *(const GAS f32x4*)(INF(5) + k * 512 + 8 * lane + 4);
            cw[k][0] = a0.x; cw[k][1] = a0.y; cw[k][2] = a0.z; cw[k][3] = a0.w; cw[k][4] = a1.x; cw[k][5] = a1.y; cw[k][6] = a1.z; cw[k][7] = a1.w; }
        const f32x4 gc0 = *(const GAS f32x4*)(INF(12) + 8 * lane), gc1 = *(const GAS f32x4*)(INF(12) + 8 * lane + 4);
        const float gc[8] = {gc0.x, gc0.y, gc0.z, gc0.w, gc1.x, gc1.y, gc1.z, gc1.w};
#pragma nounroll
        for (int h4 = 0; h4 < 2; ++h4) {
            const int s0 = 64 * qt + 8 * w + 4 * h4; const bf16* rowp = WSB(WS_PROJ) + (tok0 + s0) * NPROJ + 8 * lane;
            v4u zv[6], bgv[4];
#pragma unroll
            for (int i = 0; i < 6; ++i) { const bool ok = (s0 - 2 + i) >= 0; const bf16* rp = rowp + (ptrdiff_t)(ok ? i - 2 : 0) * NPROJ; zv[i] = __builtin_nontemporal_load((const GAS v4u*)(rp + COL_CG)); if (!ok) { zv[i] = (v4u){0u, 0u, 0u, 0u}; } }
#pragma unroll
            for (int i = 0; i < 4; ++i) bgv[i] = __builtin_nontemporal_load((const GAS v4u*)(rowp + (size_t)i * NPROJ + COL_BG));
            float z[6][8];
#pragma unroll
            for (int i = 0; i < 6; ++i) { z[i][0] = bflo(zv[i].x); z[i][1] = bfhi(zv[i].x); z[i][2] = bflo(zv[i].y); z[i][3] = bfhi(zv[i].y); z[i][4] = bflo(zv[i].z); z[i][5] = bfhi(zv[i].z); z[i][6] = bflo(zv[i].w); z[i][7] = bfhi(zv[i].w); }
#pragma unroll
            for (int i = 0; i < 4; ++i) {
                const float bgf[8] = {bflo(bgv[i].x), bfhi(bgv[i].x), bflo(bgv[i].y), bfhi(bgv[i].y), bflo(bgv[i].z), bfhi(bgv[i].z), bflo(bgv[i].w), bfhi(bgv[i].w)};
                float v[8], s2 = 0.f;
#pragma unroll
                for (int e = 0; e < 8; ++e) { v[e] = bgf[e] * (cw[0][e] * z[i][e] + cw[1][e] * z[i + 1][e] + cw[2][e] * z[i + 2][e]); s2 += v[e] * v[e]; }
                const float rstd = 1.0f / sqrtf(wave_sum(s2) * (1.f / 512.f) + EPS);
                v4u o; o.x = pk2(v[0] * rstd * gc[0], v[1] * rstd * gc[1]); o.y = pk2(v[2] * rstd * gc[2], v[3] * rstd * gc[3]); o.z = pk2(v[4] * rstd * gc[4], v[5] * rstd * gc[5]); o.w = pk2(v[6] * rstd * gc[6], v[7] * rstd * gc[7]);
                *(GAS v4u*)(WSB(WS_MIXED) + (tok0 + s0 + i) * DM + 8 * lane) = o; }
        } }
    }
#endif
    __syncthreads();
#undef FRESH_LANE
#undef GATE
#undef LANE_VARS
#undef VLANE
}

struct RowRaw { unsigned long long z[4], b[4]; float ir; };
template <bool FINAL>
__device__ __forceinline__ void resnorm_load(RowRaw& q, const bf16* Zb, const bf16* hb, const float* rstd_io, int m, int lane) {
    const GAS unsigned long long* zr = (const GAS unsigned long long*)(Zb + (size_t)m * DM) + lane; const GAS unsigned long long* br = (const GAS unsigned long long*)(hb + (size_t)m * DM) + lane;
#pragma unroll
    for (int j = 0; j < 4; ++j) { q.z[j] = __builtin_nontemporal_load(zr + 64 * j); q.b[j] = FINAL ? __builtin_nontemporal_load(br + 64 * j) : br[64 * j]; }
    q.ir = rstd_io[m];
}
template <bool FINAL>
__device__ __forceinline__ void resnorm_rows(Frame& F, const bf16* Zb, const float* g1, bf16* hb, float* rstd_io, float* outf) {
    const int NGW = F.G * NWAVES, lane = F.lane;
    const bool xal = (F.G == 256); const int gwx = xal ? (F.vx * SEQ + F.vr * NWAVES + F.wave) : (F.vcu * NWAVES + F.wave); const int rstep = xal ? 256 : NGW; const int nrow = xal ? F.vx * SEQ + SEQ : MTOK;
    f32x4 gg[4];
#pragma unroll
    for (int j = 0; j < 4; ++j) gg[j] = ((const GAS f32x4*)g1 + lane)[64 * j];
    RowRaw cur[2], nxt[2];
    if (gwx < nrow) {
#pragma unroll
        for (int r = 0; r < 2; ++r) resnorm_load<FINAL>(cur[r], Zb, hb, rstd_io, (gwx + r * rstep) < nrow ? (gwx + r * rstep) : gwx, lane); }
    for (int m0 = gwx; m0 < nrow; m0 += 2 * rstep) {
        const int mn = m0 + 2 * rstep;
        if (mn < nrow) {
#pragma unroll
            for (int r = 0; r < 2; ++r) resnorm_load<FINAL>(nxt[r], Zb, hb, rstd_io, (mn + r * rstep) < nrow ? (mn + r * rstep) : mn, lane); }
#pragma unroll
        for (int r = 0; r < 2; ++r) { const int m = m0 + r * rstep; float s2 = 0.f; f32x4 z[4], h[4]; const float ir = 1.0f / cur[r].ir;
#pragma unroll
            for (int j = 0; j < 4; ++j) { const unsigned lo = (unsigned)cur[r].z[j], hi = (unsigned)(cur[r].z[j] >> 32); z[j] = (f32x4){bflo(lo), bfhi(lo), bflo(hi), bfhi(hi)};
                const unsigned l2 = (unsigned)cur[r].b[j], h2_ = (unsigned)(cur[r].b[j] >> 32); h[j] = (f32x4){bflo(l2), bfhi(l2), bflo(h2_), bfhi(h2_)} * ir;
                s2 += (z[j].x * z[j].x + z[j].y * z[j].y) + (z[j].z * z[j].z + z[j].w * z[j].w); }
            const float rstd = 1.0f / sqrtf(wave_sum(s2) * (1.f / DM) + EPS);
            float h2 = 0.f;
#pragma unroll
            for (int j = 0; j < 4; ++j) { h[j] = h[j] + z[j] * rstd * gg[j]; h2 += (h[j].x * h[j].x + h[j].y * h[j].y) + (h[j].z * h[j].z + h[j].w * h[j].w); }
            if (FINAL) { if (m < nrow) {
#pragma unroll
                for (int j = 0; j < 4; ++j) __builtin_nontemporal_store(h[j], (GAS f32x4*)(outf + (size_t)m * DM) + lane + 64 * j); } }
            else {
                const float rs2 = 1.0f / sqrtf(wave_sum(h2) * (1.f / DM) + EPS);
                if (m < nrow) { GAS unsigned long long* o8 = (GAS unsigned long long*)(hb + (size_t)m * DM) + lane;
#pragma unroll
                    for (int j = 0; j < 4; ++j) { const f32x4 y = h[j] * rs2; o8[64 * j] = (unsigned long long)pk2(y.x, y.y) | ((unsigned long long)pk2(y.z, y.w) << 32); }
                    if (lane == 0) rstd_io[m] = rs2; } }
        }
        cur[0] = nxt[0]; cur[1] = nxt[1];
    }
}

#ifndef GEMM_ALIGN
#define GEMM_ALIGN true
#endif
#ifndef GEMM_SP2
#define GEMM_SP2 true
#endif
#ifndef GEMM_A_AUX
#define GEMM_A_AUX 0
#endif
#ifndef GEMM_A_AUX_DOWN
#define GEMM_A_AUX_DOWN 0
#endif
__device__ __forceinline__ void warm_buffer(const void* p, size_t bytes) {
    const v4u* q = (const v4u*)p; const size_t n = bytes / 16, stride = (size_t)gridDim.x * 512;
    v4u acc = (v4u){0u, 0u, 0u, 0u};
    for (size_t i = (size_t)blockIdx.x * 512 + threadIdx.x; i < n; i += stride) { const v4u v = *(const GAS v4u*)(q + i); acc.x |= v.x; acc.y |= v.y; acc.z |= v.z; acc.w |= v.w; }
    asm volatile("" :: "v"(acc.x), "v"(acc.y), "v"(acc.z), "v"(acc.w));
}
constexpr int N_PHASES = 13;
__device__ __forceinline__ void p2_fold_units(Frame& F, const Args& A, const bf16* kvb, int r, int half) {
            if (r < 4) { const int h = r;
                pg8::Gemm g{kvb + h * 256, WSB(WS_WQ) + h * 256, MEM_LEN, DM, 256, 2048, DM}; pg8::FixedUnit S{0, 2 * half, 0, 2 * half + 1};
                pg8::EpiStore E{WSB(WS_MBT) + (size_t)F.vx * DM * DM + (size_t)(h * 256) * DM, DM, C2_X, nullptr, 0};
                pg8::gemm_phase<pg8::EpiStore, pg8::FixedUnit, GEMM_ALIGN, GEMM_SP2>(F.lds + RING_OFF, g, S, E); }
            else { const int h = r - 4;
                pg8::Gemm g{WSB(WS_WO) + h * 256, kvb + DM + h * 256, DM, MEM_LEN, 256, DM, 2048}; pg8::FixedUnit S{2 * half, 0, 2 * half + 1, 0};
                pg8::EpiStore E{WSB(WS_NBT) + (size_t)F.vx * DM * DM + h * 256, DM, 1.0f, nullptr, 0};
                pg8::gemm_phase<pg8::EpiStore, pg8::FixedUnit, GEMM_ALIGN, GEMM_SP2>(F.lds + RING_OFF, g, S, E); }
}

__global__ void __launch_bounds__(NWAVES * 64, 2) hymba_fwd(Args args) {
    const Args& A = args;
    extern __shared__ __attribute__((aligned(16))) unsigned char lds[];
    Frame F;
    F.lds = (LAS unsigned char*)lds;
    F.MISC = (volatile LAS unsigned*)(F.lds + MISC_OFF);
    F.tid = threadIdx.x; F.lane = F.tid & 63; F.wave = __builtin_amdgcn_readfirstlane(F.tid >> 6);
    F.G = gridDim.x; { const int bx = blockIdx.x; F.vcu = (F.G % 8 == 0) ? (bx % 8) * (F.G / 8) + bx / 8 : bx; }
    unsigned char* ws = args.ws;
    F.ctl = (gu32*)(ws + WS_CTL);
    for (int u = F.tid; u < (LDS_BYTES - LDSCTL_OFF) / 4; u += NWAVES * 64) ((LAS unsigned*)(F.lds + LDSCTL_OFF))[u] = 0u;
    __syncthreads();
    const bool use_bar = true;
    XcdBarrier bar; bar.bar = (unsigned*)(F.ctl + CW_BAR) + args.bar_region * XCD_BAR_WORDS; bar.x = 0; bar.st = nullptr;
    if (use_bar) bar = xcd_barrier_post((unsigned*)(F.ctl + CW_BAR) + args.bar_region * XCD_BAR_WORDS, F.MISC + 8);
    const int lo = args.ph_lo, hi = args.ph_hi;
    F.vx = F.vcu >> 5; F.vr = F.vcu & 31; bool xl = false;
#ifndef ONLY
#define ONLY -1
#endif
#define IN(k) ((ONLY < 0 || ONLY == (k)) && lo <= (k) && (k) < hi)
#define SEAM(k) do { if (IN(k) && IN((k) + 1)) xcd_barrier(bar, xl); } while (0)

    if (IN(0)) { p0_prologue(F, A); }
    if (IN(0) && IN(1)) {
        xcd_barrier(bar, false);
#ifndef FORCE_FALLBACK
        if (F.MISC[10] != 0u) { xl = true; F.vx = (int)__builtin_amdgcn_readfirstlane(bar.x); F.vr = (int)__builtin_amdgcn_readfirstlane(F.MISC[11]); }
#endif
    }
    if (IN(1)) {
        pg8::Gemm g{WSB(WS_XN), WSB(WS_WIN), MTOK, NPROJ, DM}; pg8::HybridOrder S; S.init(MTOK, NPROJ, F.G, (int)blockIdx.x, F.vx, F.vr);
        pg8::EpiStore E{WSB(WS_PROJ), NPROJ, 1.0f, nullptr, 0, 2, 6, COL_CG, COL_KSL / 256, COL_KW / 256 + 1, (const float*)(A.ws + WS_ROPE)};
        pg8::gemm_phase<pg8::EpiStore, pg8::HybridOrder, GEMM_ALIGN, GEMM_SP2>(F.lds + RING_OFF, g, S, E);
    } SEAM(1);
    if (IN(2)) {
        if (F.vr >= 8 && F.vr < 24) { compress_unit(F, A, 16 * F.vx + F.vr - 8);
#if defined(PROBE_DUP) && PROBE_DUP == 15
            compress_unit(F, A, 16 * F.vx + F.vr - 8);
#endif
        }
        else {
            const int r = F.vr & 7, half = F.vr >> 4;
            { pg8::Gemm g{WSB(WS_MN), WSB(WS_WKV), MMEM, 2 * DM, DM}; pg8::FixedUnit S{F.vx, r, -1, -1};
              pg8::EpiStore E{WSB(WS_KVX), 2 * DM, 1.0f, nullptr, 0};
              pg8::gemm_phase<pg8::EpiStore, pg8::FixedUnit, GEMM_ALIGN, GEMM_SP2>(F.lds + RING_OFF, g, S, E); }
            asm volatile("s_waitcnt vmcnt(0)" ::: "memory"); __syncthreads();
            const bf16* kvb = WSB(WS_KVX) + (size_t)(F.vx * MEM_LEN) * 2048;
            p2_fold_units(F, A, kvb, r, half);
#if defined(PROBE_DUP) && PROBE_DUP == 14
            p2_fold_units(F, A, kvb, r, half);
#endif
        }
    } SEAM(2);
    if (IN(3)) {
        for (int p = (F.G == 256 ? F.vx * 32 + F.vr : F.vcu); p < 256; p += F.G) { const int b = p >> 5, s = p & 31;
#pragma nounroll
            for (int h2 = 0; h2 < 2; ++h2) nsa_unit(F, A, b, h2 ? s : 63 - s); }
    } SEAM(3);
#if defined(PROBE_DUP) && PROBE_DUP == 9
    if (IN(4)) { for (int rep_ = 0; rep_ < 8; ++rep_) xcd_barrier(bar, xl); }
#endif
    if (IN(4)) {
        pg8::Gemm g{WSB(WS_MIXED), WSB(WS_WOUT), MTOK, DM, DM}; pg8::HybridOrder S; S.init(MTOK, DM, F.G, (int)blockIdx.x, F.vx, F.vr);
        pg8::EpiStore E{WSB(WS_Z), DM, 1.0f, nullptr, 0};
        pg8::gemm_phase<pg8::EpiStore, pg8::HybridOrder, GEMM_ALIGN, GEMM_SP2, GEMM_A_AUX>(F.lds + RING_OFF, g, S, E);
    } SEAM(4);
    if (IN(5)) { resnorm_rows<false>(F, WSB(WS_Z), INF(15), WSB(WS_H), (float*)(A.ws + WS_RSTD), nullptr); } SEAM(5);
    if (IN(6)) {
        pg8::Gemm g{WSB(WS_H), WSB(WS_MBT) + (size_t)F.vx * DM * DM, MTOK, DM, DM}; pg8::HybridOrder S; S.init(MTOK, DM, F.G, (int)blockIdx.x, F.vx, F.vr);
        pg8::EpiSoftmax E{WSB(WS_QX), DM, (LAS float*)(F.lds + WSF_OFF)};
        pg8::gemm_phase<pg8::EpiSoftmax, pg8::HybridOrder, true, GEMM_SP2>(F.lds + RING_OFF, g, S, E);
    } SEAM(6);
    if (IN(8)) {
        pg8::Gemm g{WSB(WS_QX), WSB(WS_NBT) + (size_t)F.vx * DM * DM, MTOK, DM, DM}; pg8::HybridOrder S; S.init(MTOK, DM, F.G, (int)blockIdx.x, F.vx, F.vr);
        pg8::EpiStore E{WSB(WS_Z), DM, 1.0f, nullptr, 0};
        pg8::gemm_phase<pg8::EpiStore, pg8::HybridOrder, GEMM_ALIGN, GEMM_SP2, GEMM_A_AUX>(F.lds + RING_OFF, g, S, E);
    } SEAM(8);
    if (IN(9)) { resnorm_rows<false>(F, WSB(WS_Z), INF(21), WSB(WS_H), (float*)(A.ws + WS_RSTD), nullptr); } SEAM(9);
#ifdef WARM_W
    if (IN(10)) { warm_buffer(WSB(WS_WGU), (size_t)2 * DFF * DM * 2); warm_buffer(WSB(WS_WD), (size_t)DM * DFF * 2); }
#endif
#ifdef PROBE_SLEEP_US
    if (IN(10)) { const unsigned long long t0_ = __builtin_amdgcn_s_memrealtime(); while (__builtin_amdgcn_s_memrealtime() - t0_ < (unsigned long long)PROBE_SLEEP_US * 100ull) __builtin_amdgcn_s_sleep(64); }
#endif
    if (IN(10)) {
        pg8::Gemm g{WSB(WS_H), WSB(WS_WGU), MTOK, 2 * DFF, DM}; pg8::HybridOrder S; S.init(MTOK, 2 * DFF, F.G, (int)blockIdx.x, F.vx, F.vr);
        pg8::EpiSwiGLU E{WSB(WS_HB) + (size_t)F.vx * HB_BATCH_SHIFT, HB_PITCH};
#if defined(PROBE_DUP) && PROBE_DUP == 11
        for (int rep_ = 0; rep_ < 2; ++rep_)
#endif
        pg8::gemm_phase<pg8::EpiSwiGLU, pg8::HybridOrder, GEMM_ALIGN, GEMM_SP2>(F.lds + RING_OFF, g, S, E);
    } SEAM(10);
#if defined(PROBE_DUP) && PROBE_DUP == 12
    if (IN(11)) {
        pg8::Gemm g{WSB(WS_HB) + (size_t)F.vx * HB_BATCH_SHIFT, WSB(WS_WD), MTOK, DM, DFF, 64, 0}; pg8::HybridOrder S; S.init(MTOK, DM, F.G, (int)blockIdx.x, F.vx, F.vr);
        pg8::EpiStore E{WSB(WS_MBT), DM, 1.0f, nullptr, 0};
        pg8::gemm_phase<pg8::EpiStore, pg8::HybridOrder, GEMM_ALIGN, GEMM_SP2, GEMM_A_AUX_DOWN>(F.lds + RING_OFF, g, S, E);
        xcd_barrier(bar, xl);
    }
#endif
    if (IN(11)) {
        #ifdef HB_TILED
        pg8::Gemm g{WSB(WS_HB) + (size_t)F.vx * HB_BATCH_SHIFT, WSB(WS_WD), MTOK, DM, DFF, 64, 0, 32768};
#else
        pg8::Gemm g{WSB(WS_HB) + (size_t)F.vx * HB_BATCH_SHIFT, WSB(WS_WD), MTOK, DM, DFF, HB_PITCH, 0};
#endif
        pg8::HybridOrder S; S.init(MTOK, DM, F.G, (int)blockIdx.x, F.vx, F.vr);
#ifdef REV_DOWN
        S.rev = 1;
#endif
        pg8::EpiStore E{WSB(WS_Z), DM, 1.0f, nullptr, 0};
        pg8::gemm_phase<pg8::EpiStore, pg8::HybridOrder, GEMM_ALIGN, GEMM_SP2, GEMM_A_AUX_DOWN>(F.lds + RING_OFF, g, S, E);
    } SEAM(11);
    if (IN(12)) { resnorm_rows<true>(F, WSB(WS_Z), INF(25), WSB(WS_H), (float*)(A.ws + WS_RSTD), A.out); }
#undef IN
#undef SEAM
}

#ifndef MK_MULTI
#define MK_MULTI 0
#endif
extern "C" void kernel_launch(void* const* d_in, const int* in_sizes, int n_in, void* d_out, int out_size, void* d_ws, size_t ws_size, hipStream_t stream) {
    static int grid = 0;
    if (grid == 0) {
        if (n_in != 26 || in_sizes[0] != MTOK * DM || out_size != MTOK * DM || ws_size < WS_END) { fprintf(stderr, "kernel_launch: unexpected shapes (n_in %d, in0 %d, out %d, ws %zu); nothing launched\n", n_in, n_in > 0 ? in_sizes[0] : -1, out_size, ws_size); grid = -1; return; }
        int dev = 0, cus = 0, per_cu = 0;
        if (hipGetDevice(&dev) != hipSuccess || hipDeviceGetAttribute(&cus, hipDeviceAttributeMultiprocessorCount, dev) != hipSuccess) { grid = -1; return; }
        if (hipFuncSetAttribute((const void*)hymba_fwd, hipFuncAttributeMaxDynamicSharedMemorySize, LDS_BYTES) != hipSuccess) { fprintf(stderr, "kernel_launch: hipFuncSetAttribute failed\n"); grid = -1; return; }
        if (hipOccupancyMaxActiveBlocksPerMultiprocessor(&per_cu, (const void*)hymba_fwd, NWAVES * 64, LDS_BYTES) != hipSuccess || per_cu < 1)
            fprintf(stderr, "kernel_launch: note: occupancy query reports %d workgroups per CU\n", per_cu);
        (void)hipGetLastError();
        if (cus != 256) { fprintf(stderr, "kernel_launch: built for a 256-CU device (8 XCCs x 32), found %d CUs; nothing launched\n", cus); grid = -1; return; }
        grid = cus;
    }
    if (grid < 0) return;
    if (hipMemsetAsync((char*)d_ws + WS_CTL, 0, CTL_ZERO_BYTES, stream) != hipSuccess) { fprintf(stderr, "kernel_launch: hipMemsetAsync failed\n"); return; }
    Args a{};
    for (int i = 0; i < 26; ++i) a.in[i] = d_in[i];
    a.out = (float*)d_out; a.ws = (unsigned char*)d_ws;
#if MK_MULTI
    for (int p = 0; p < N_PHASES; ++p) { a.ph_lo = p; a.ph_hi = p + 1; a.bar_region = p; hipLaunchKernelGGL(hymba_fwd, dim3(grid), dim3(NWAVES * 64), LDS_BYTES, stream, a); }
#elif defined(CUM_PHASE)
    a.ph_lo = 0; a.ph_hi = CUM_PHASE + 1; a.bar_region = 0; hipLaunchKernelGGL(hymba_fwd, dim3(grid), dim3(NWAVES * 64), LDS_BYTES, stream, a);
    a.ph_lo = 0; a.ph_hi = N_PHASES; a.bar_region = 1; hipLaunchKernelGGL(hymba_fwd, dim3(grid), dim3(NWAVES * 64), LDS_BYTES, stream, a);
#elif defined(REP_PHASE)
    a.ph_lo = 0; a.ph_hi = REP_PHASE + 1; a.bar_region = 0; hipLaunchKernelGGL(hymba_fwd, dim3(grid), dim3(NWAVES * 64), LDS_BYTES, stream, a);
    a.ph_lo = REP_PHASE; a.ph_hi = REP_PHASE + 1; a.bar_region = 1; hipLaunchKernelGGL(hymba_fwd, dim3(grid), dim3(NWAVES * 64), LDS_BYTES, stream, a);
    a.ph_lo = REP_PHASE + 1; a.ph_hi = N_PHASES; a.bar_region = 2; hipLaunchKernelGGL(hymba_fwd, dim3(grid), dim3(NWAVES * 64), LDS_BYTES, stream, a);
#else
    a.ph_lo = 0; a.ph_hi = N_PHASES;
    hipLaunchKernelGGL(hymba_fwd, dim3(grid), dim3(NWAVES * 64), LDS_BYTES, stream, a);
#endif
    const hipError_t le = hipPeekAtLastError();
    if (le != hipSuccess) fprintf(stderr, "kernel_launch: launch failed: %s\n", hipGetErrorName(le));
}
```

```cpp
#ifndef GEMM_WGM
#define GEMM_WGM 8
#endif
#include <hip/hip_runtime.h>
#include <hip/hip_bf16.h>
#include <cstdio>
#include <cstdint>
#include <cmath>
namespace pg8 {
#define PG8_LAS __attribute__((address_space(3)))
typedef unsigned short bf16_t;
typedef short bf16x8 __attribute__((ext_vector_type(8)));
typedef float f32x4 __attribute__((ext_vector_type(4)));
typedef unsigned u32x4 __attribute__((ext_vector_type(4)));
constexpr int BM = 256, BK = 64, HALF = 128, HTB = HALF * BK * 2  , STAGE_BYTES = 8 * HTB, NXCD = 8, WGM = GEMM_WGM;

__host__ __device__ __forceinline__ int lds_byte(int r, int c) { return (r >> 3) * 1024 + (r & 7) * 128 + ((((c >> 3) ^ (r >> 1)) & 7) << 4) + (c & 7) * 2; }
__host__ __device__ __forceinline__ void stage_rc(int b, int& R, int& C) { const int blk = b / 1024, r8 = (b % 1024) / 128, slot = (b % 128) / 16; R = blk * 8 + r8; C = ((slot ^ (R >> 1)) & 7) << 3; }
__host__ __device__ __forceinline__ int perm32(int rho) { const int n = rho >> 4, i = rho & 15; return 8 * (i >> 2) + 4 * n + (i & 3); }

struct Unit { int pm, pn; };
struct Gemm { const bf16_t* A; const bf16_t* Bt; int M, N, K; int lda, ldb; int ksA; };

struct StaticOrder {
    int nM, nN, nwg, G, c;
    __host__ __device__ void init(int M, int N, int G_, int c_) { nM = M / BM; nN = N / BM; nwg = nM * nN; G = G_; c = c_; }
    __host__ __device__ bool next(int i, Unit& u) const {
        const long L = (long)i * G + c; if (L >= nwg) return false;
        int wgid = (int)L; { const int q = nwg / NXCD, r = nwg % NXCD, xcd = wgid % NXCD, off = wgid / NXCD; wgid = (xcd < r ? xcd * (q + 1) : r * (q + 1) + (xcd - r) * q) + off; }
        const int nig = WGM * nN, gid = wgid / nig, fm = gid * WGM, gsz = (nM - fm) < WGM ? (nM - fm) : WGM;
        u.pm = fm + ((wgid % nig) % gsz); u.pn = (wgid % nig) / gsz; return true;
    }
    __device__ __forceinline__ void a_ready(const Unit&) const {}
    __device__ __forceinline__ void done(const Unit&) const {}
};

__device__ __forceinline__ unsigned cvt_pk_bf16(float lo, float hi) { unsigned r; asm volatile("v_cvt_pk_bf16_f32 %0, %1, %2" : "=v"(r) : "v"(lo), "v"(hi)); return r; }
__device__ __forceinline__ float x4_sum(float v) {
    { auto r = __builtin_amdgcn_permlane16_swap(__builtin_bit_cast(unsigned, v), __builtin_bit_cast(unsigned, v), false, false); v = __builtin_bit_cast(float, r[0]) + __builtin_bit_cast(float, r[1]); }
    { auto r = __builtin_amdgcn_permlane32_swap(__builtin_bit_cast(unsigned, v), __builtin_bit_cast(unsigned, v), false, false); v = __builtin_bit_cast(float, r[0]) + __builtin_bit_cast(float, r[1]); }
    return v; }
__device__ __forceinline__ float x4_max(float v) {
    { auto r = __builtin_amdgcn_permlane16_swap(__builtin_bit_cast(unsigned, v), __builtin_bit_cast(unsigned, v), false, false); v = fmaxf(__builtin_bit_cast(float, r[0]), __builtin_bit_cast(float, r[1])); }
    { auto r = __builtin_amdgcn_permlane32_swap(__builtin_bit_cast(unsigned, v), __builtin_bit_cast(unsigned, v), false, false); v = fmaxf(__builtin_bit_cast(float, r[0]), __builtin_bit_cast(float, r[1])); }
    return v; }
__device__ __forceinline__ void store16_wt(void* p, u32x4 v) { asm volatile("global_store_dwordx4 %0, %1, off sc1\n\ts_nop 1" :: "v"(p), "v"(v) : "memory"); }
__device__ __forceinline__ void pair_store(bf16_t* O, int ldc, int row, int fr, int col0, u32x4 w0, u32x4 w1) {
    const bool lo = fr < 8; u32x4 give, recv, dA, dB;
    give.x = lo ? w1.x : w0.x; give.y = lo ? w1.y : w0.y; give.z = lo ? w1.z : w0.z; give.w = lo ? w1.w : w0.w;
    recv.x = (unsigned)__builtin_amdgcn_update_dpp(0, (int)give.x, 0x128, 0xf, 0xf, false); recv.y = (unsigned)__builtin_amdgcn_update_dpp(0, (int)give.y, 0x128, 0xf, 0xf, false);
    recv.z = (unsigned)__builtin_amdgcn_update_dpp(0, (int)give.z, 0x128, 0xf, 0xf, false); recv.w = (unsigned)__builtin_amdgcn_update_dpp(0, (int)give.w, 0x128, 0xf, 0xf, false);
    dA.x = lo ? w0.x : recv.x; dA.y = lo ? w0.y : recv.y; dA.z = lo ? w0.z : recv.z; dA.w = lo ? w0.w : recv.w;
    dB.x = lo ? recv.x : w1.x; dB.y = lo ? recv.y : w1.y; dB.z = lo ? recv.z : w1.z; dB.w = lo ? recv.w : w1.w;
    int rA = row - fr + (fr & 7); asm volatile("" : "+v"(rA));
    const int cc = col0 + (lo ? 0 : 32);
    *(u32x4*)(O + (size_t)rA * ldc + cc) = dA; *(u32x4*)(O + (size_t)(rA + 8) * ldc + cc) = dB;
}
struct EpiStore {
    static constexpr bool PERM = true, AFTER_DRAIN = false;
    bf16_t* O; int ldc; float scale; const float* rscale; int nt_pn; int zlo, zhi, zcol; int rlo, rhi; const float* rtab;
    __device__ __forceinline__ void operator()(const f32x4 (&acc)[2][2][4][2], const Unit& u, int wr, int wc, int fr, int fq) const {
        const int row0 = u.pm * BM + wr * 64 + fr; const float sc = scale;
        if (u.pn >= zlo && u.pn < zhi) {
            const int zc0 = zcol + 128 * (u.pn - zlo) + wc * 32 + 8 * fq;
#pragma unroll
            for (int ai = 0; ai < 2; ++ai)
#pragma unroll
                for (int m = 0; m < 4; ++m) { const f32x4 v0 = acc[ai][0][m][0] * acc[ai][1][m][0], v1 = acc[ai][0][m][1] * acc[ai][1][m][1];
                    u32x4 w; w.x = cvt_pk_bf16(v0[0], v0[1]); w.y = cvt_pk_bf16(v0[2], v0[3]); w.z = cvt_pk_bf16(v1[0], v1[1]); w.w = cvt_pk_bf16(v1[2], v1[3]);
                    *(u32x4*)(O + (size_t)(row0 + ai * HALF + m * 16) * ldc + zc0) = w; }
            return; }
        const int col0 = u.pn * BM + wc * 64 + 8 * fq;
        if (u.pn >= rlo && u.pn < rhi && wc < 2) {
#pragma unroll
            for (int ai = 0; ai < 2; ++ai) {
                f32x4 tc0[4], tc1[4], ts0[4], ts1[4];
#pragma unroll
                for (int m = 0; m < 4; ++m) { const float* tb = rtab + (size_t)(row0 + ai * HALF + m * 16) * 64 + 8 * fq; tc0[m] = *(const f32x4*)tb; tc1[m] = *(const f32x4*)(tb + 4); ts0[m] = *(const f32x4*)(tb + 32); ts1[m] = *(const f32x4*)(tb + 36); }
#pragma unroll
                for (int m = 0; m < 4; ++m) { const int row = row0 + ai * HALF + m * 16;
                    const f32x4 c0 = tc0[m], c1 = tc1[m], s0 = ts0[m], s1 = ts1[m];
                    const f32x4 a0 = acc[ai][0][m][0], a1 = acc[ai][0][m][1], b0 = acc[ai][1][m][0], b1 = acc[ai][1][m][1];
                    const f32x4 o0 = a0 * c0 - b0 * s0, o1 = a1 * c1 - b1 * s1, p0 = b0 * c0 + a0 * s0, p1 = b1 * c1 + a1 * s1;
                    u32x4 w, w2; w.x = cvt_pk_bf16(o0[0], o0[1]); w.y = cvt_pk_bf16(o0[2], o0[3]); w.z = cvt_pk_bf16(o1[0], o1[1]); w.w = cvt_pk_bf16(o1[2], o1[3]);
                    w2.x = cvt_pk_bf16(p0[0], p0[1]); w2.y = cvt_pk_bf16(p0[2], p0[3]); w2.z = cvt_pk_bf16(p1[0], p1[1]); w2.w = cvt_pk_bf16(p1[2], p1[3]);
                    pair_store(O, ldc, row, fr, col0, w, w2); } }
            return; }
#pragma unroll
        for (int ai = 0; ai < 2; ++ai)
#pragma unroll
            for (int m = 0; m < 4; ++m) { const float rs = rscale ? sc * rscale[row0 + ai * HALF + m * 16] : sc; u32x4 wq[2];
#pragma unroll
                for (int bj = 0; bj < 2; ++bj) { const f32x4 v0 = acc[ai][bj][m][0] * rs, v1 = acc[ai][bj][m][1] * rs;
                    wq[bj].x = cvt_pk_bf16(v0[0], v0[1]); wq[bj].y = cvt_pk_bf16(v0[2], v0[3]); wq[bj].z = cvt_pk_bf16(v1[0], v1[1]); wq[bj].w = cvt_pk_bf16(v1[2], v1[3]); }
                pair_store(O, ldc, row0 + ai * HALF + m * 16, fr, col0, wq[0], wq[1]); }
    }
};
__device__ __forceinline__ float silu_f(float x) { return x * __builtin_amdgcn_rcpf(1.0f + __builtin_amdgcn_exp2f(-1.4426950408889634f * x)); }
struct EpiSwiGLU {
    static constexpr bool PERM = true, AFTER_DRAIN = false;
    mutable float rsc[2][4]; mutable int rs_pm;
    const float* sqh;
    bf16_t* O; int ldc;
    __device__ __forceinline__ void operator()(const f32x4 (&acc)[2][2][4][2], const Unit& u, int wr, int wc, int fr, int fq) const {
        const int row0 = u.pm * BM + wr * 64 + fr; const int col0 = u.pn * HALF + wc * 32 + 8 * fq;
#ifdef HB_TILED
        bf16_t* tp = O + ((size_t)(u.pm * (ldc / 64) + 2 * u.pn + (wc >> 1)) * BM + wr * 64 + fr) * 64 + (wc & 1) * 32 + 8 * fq;
#endif
        if (rs_pm != u.pm) {
#pragma unroll
            for (int ai = 0; ai < 2; ++ai)
#pragma unroll
                for (int m = 0; m < 4; ++m) { const f32x4 s4 = *(const f32x4*)(sqh + (size_t)(row0 + ai * HALF + m * 16) * 4); rsc[ai][m] = __builtin_amdgcn_rsqf(((s4[0] + s4[1]) + (s4[2] + s4[3])) * (1.f / 1024.f) + 1e-6f); }
            rs_pm = u.pm; }
#pragma unroll
        for (int ai = 0; ai < 2; ++ai)
#pragma unroll
            for (int m = 0; m < 4; ++m) {
#ifdef HB_TILED
                bf16_t* rowp = tp + (ai * HALF + m * 16) * 64;
#else
                bf16_t* rowp = O + (size_t)(row0 + ai * HALF + m * 16) * ldc + col0;
#endif
                const f32x4 g0 = acc[ai][0][m][0], g1 = acc[ai][0][m][1], u0 = acc[ai][1][m][0], u1 = acc[ai][1][m][1];
                const float rs = rsc[ai][m], c1 = -1.4426950408889634f * rs, c2 = rs * rs;
                float h[8];
#pragma unroll
                for (int e = 0; e < 4; ++e) { h[e] = (g0[e] * u0[e]) * c2 * __builtin_amdgcn_rcpf(1.0f + __builtin_amdgcn_exp2f(c1 * g0[e])); h[4 + e] = (g1[e] * u1[e]) * c2 * __builtin_amdgcn_rcpf(1.0f + __builtin_amdgcn_exp2f(c1 * g1[e])); }
                u32x4 w; w.x = cvt_pk_bf16(h[0], h[1]); w.y = cvt_pk_bf16(h[2], h[3]); w.z = cvt_pk_bf16(h[4], h[5]); w.w = cvt_pk_bf16(h[6], h[7]);
#ifdef HB_NT
                __builtin_nontemporal_store(w, (u32x4*)rowp); }
#else
                *(u32x4*)rowp = w; }
#endif
    }
};

struct HybridOrder {
    StaticOrder so; bool xm; int nN, ppx, vx, vr, rev;
    __host__ __device__ void init(int M, int N, int G, int c, int vx_, int vr_) { so.init(M, N, G, c); nN = N / BM; ppx = (M / BM) / 8; vx = vx_; vr = vr_; rev = 0; xm = (G == 256) && ((M / BM) % 8 == 0); }
    __host__ __device__ bool next(int i, Unit& u) const {
        if (!xm) return so.next(i, u);
        const int idx = i * 32 + vr, per = ppx * nN; if (idx >= per) return false;
        const int gsz = ppx < WGM ? ppx : WGM, gunits = gsz * nN, g2 = idx / gunits, w = idx - g2 * gunits;
        u.pm = vx * ppx + (rev ? ppx / gsz - 1 - g2 : g2) * gsz + (w % gsz); u.pn = w / gsz; return true;
    }
    __device__ __forceinline__ void a_ready(const Unit&) const {}
    __device__ __forceinline__ void done(const Unit&) const {}
};
struct FixedUnit { int pm, pn, pm1, pn1;
    __host__ __device__ bool next(int i, Unit& u) const { if (i == 0) { u.pm = pm; u.pn = pn; return true; } if (i == 1 && pm1 >= 0) { u.pm = pm1; u.pn = pn1; return true; } return false; }
    __device__ __forceinline__ void a_ready(const Unit&) const {}
    __device__ __forceinline__ void done(const Unit&) const {} };
struct EpiSoftmax {
    static constexpr bool PERM = true, AFTER_DRAIN = false;
    bf16_t* O; int ldc; PG8_LAS float* tab; const float* sqh;
    __device__ __forceinline__ void operator()(const f32x4 (&acc_)[2][2][4][2], const Unit& u, int wr, int wc, int fr, int fq) const {
        f32x4 (&acc)[2][2][4][2] = const_cast<f32x4 (&)[2][2][4][2]>(acc_);
        PG8_LAS float* MX = tab; PG8_LAS float* SM = tab + 1024;
        const int rl0 = wr * 64 + fr;
        float rsv[2][4];
#pragma unroll
        for (int ai = 0; ai < 2; ++ai)
#pragma unroll
            for (int m = 0; m < 4; ++m) { const f32x4 s4 = *(const f32x4*)(sqh + (size_t)(u.pm * BM + ai * HALF + m * 16 + rl0) * 4); rsv[ai][m] = __builtin_amdgcn_rsqf(((s4[0] + s4[1]) + (s4[2] + s4[3])) * (1.f / 1024.f) + 1e-6f); }
#pragma unroll
        for (int ai = 0; ai < 2; ++ai)
#pragma unroll
            for (int m = 0; m < 4; ++m) { float mx = -INFINITY;
#pragma unroll
                for (int bj = 0; bj < 2; ++bj)
#pragma unroll
                    for (int n = 0; n < 2; ++n) { const f32x4 x = acc[ai][bj][m][n]; mx = fmaxf(mx, fmaxf(fmaxf(x[0], x[1]), fmaxf(x[2], x[3]))); }
                mx *= rsv[ai][m];
                mx = fmaxf(mx, __shfl_xor(mx, 16)); mx = fmaxf(mx, __shfl_xor(mx, 32));
                if (fq == 0) MX[(ai * HALF + m * 16 + rl0) * 4 + wc] = mx; }
        asm volatile("s_waitcnt lgkmcnt(0)" ::: "memory"); __builtin_amdgcn_s_barrier(); asm volatile("" ::: "memory");
#pragma unroll
        for (int ai = 0; ai < 2; ++ai)
#pragma unroll
            for (int m = 0; m < 4; ++m) { const f32x4 m4 = *(const PG8_LAS f32x4*)(MX + (ai * HALF + m * 16 + rl0) * 4); const float rm = fmaxf(fmaxf(m4[0], m4[1]), fmaxf(m4[2], m4[3])); float ps = 0.f;
#pragma unroll
                for (int bj = 0; bj < 2; ++bj)
#pragma unroll
                    for (int n = 0; n < 2; ++n) { f32x4 x = acc[ai][bj][m][n]; const float rs = rsv[ai][m];
                        x[0] = __builtin_amdgcn_exp2f(__builtin_fmaf(x[0], rs, -rm)); x[1] = __builtin_amdgcn_exp2f(__builtin_fmaf(x[1], rs, -rm)); x[2] = __builtin_amdgcn_exp2f(__builtin_fmaf(x[2], rs, -rm)); x[3] = __builtin_amdgcn_exp2f(__builtin_fmaf(x[3], rs, -rm));
                        ps += (x[0] + x[1]) + (x[2] + x[3]); acc[ai][bj][m][n] = x; }
                ps += __shfl_xor(ps, 16); ps += __shfl_xor(ps, 32);
                if (fq == 0) SM[(ai * HALF + m * 16 + rl0) * 4 + wc] = ps; }
        asm volatile("s_waitcnt lgkmcnt(0)" ::: "memory"); __builtin_amdgcn_s_barrier(); asm volatile("" ::: "memory");
        const int col0 = u.pn * BM + wc * 64 + 8 * fq;
#pragma unroll
        for (int ai = 0; ai < 2; ++ai)
#pragma unroll
            for (int m = 0; m < 4; ++m) { const f32x4 s4 = *(const PG8_LAS f32x4*)(SM + (ai * HALF + m * 16 + rl0) * 4); const float inv = __builtin_amdgcn_rcpf((s4[0] + s4[1]) + (s4[2] + s4[3]));
                u32x4 wq[2];
#pragma unroll
                for (int bj = 0; bj < 2; ++bj) { const f32x4 v0 = acc[ai][bj][m][0] * inv, v1 = acc[ai][bj][m][1] * inv;
                    wq[bj].x = cvt_pk_bf16(v0[0], v0[1]); wq[bj].y = cvt_pk_bf16(v0[2], v0[3]); wq[bj].z = cvt_pk_bf16(v1[0], v1[1]); wq[bj].w = cvt_pk_bf16(v1[2], v1[3]); }
                pair_store(O, ldc, u.pm * BM + ai * HALF + m * 16 + rl0, fr, col0, wq[0], wq[1]); }
    }
};
template <class Epi, class Sched, bool ALIGN_EPI = false, bool SP2 = false, int A_AUX = 0  >
__device__ __forceinline__ void gemm_phase(PG8_LAS unsigned char* lds, const Gemm g, const Sched& S, const Epi& E) {
    const int tid = threadIdx.x, wid = __builtin_amdgcn_readfirstlane(tid >> 6), lane = tid & 63, wr = wid >> 2, wc = wid & 3, fr = lane & 15, fq = lane >> 4;
    const int K = g.K, nt = K / BK, lda = g.lda ? g.lda : K, ldb = g.ldb ? g.ldb : K;
    unsigned voffA, voffB;
    { int R, C; stage_rc(tid * 16, R, C); const int Rb = Epi::PERM ? ((R & ~31) + perm32(R & 31)) : R; voffA = (unsigned)(R * lda + C) * 2u; voffB = (unsigned)(Rb * ldb + C) * 2u; }
    const size_t qstepA = (size_t)64 * lda * 2, qstepB = (size_t)64 * ldb * 2;
    const size_t kstep = (size_t)(BK * 2);
    const size_t hstepA = (size_t)HALF * lda * 2, hstepB = (size_t)HALF * ldb * 2;
    const size_t kstepA = g.ksA ? (size_t)g.ksA : kstep;
    const size_t tstepA = g.ksA ? (size_t)nt * g.ksA : 2 * hstepA, tstepB = 2 * hstepB;
    const unsigned ldsw = (unsigned)wid * 1024u;
    const int aoff = lds_byte(wr * 64 + fr, fq * 8), boff = lds_byte(wc * 32 + fr, fq * 8);
    const int aoffx = aoff ^ 64, boffx = boff ^ 64;
#define PG8_SA(b, h) (((b) * 2 + (h)) * HTB)
#define PG8_SB(b, h) ((4 + (b) * 2 + (h)) * HTB)
#define PG8_STAGE(bufoff, gbase, voff) do { _Pragma("unroll") for (int _i = 0; _i < 2; ++_i) \
        __builtin_amdgcn_global_load_lds((const unsigned*)((const char*)(gbase) + _i * qstepB + (voff)), (PG8_LAS unsigned*)(lds + (bufoff) + ldsw + _i * 8192), 16, 0, 0); } while (0)
#define PG8_STAGEA(bufoff, gbase, voff) do { _Pragma("unroll") for (int _i = 0; _i < 2; ++_i) \
        __builtin_amdgcn_global_load_lds((const unsigned*)((const char*)(gbase) + _i * qstepA + (voff)), (PG8_LAS unsigned*)(lds + (bufoff) + ldsw + _i * 8192), 16, 0, A_AUX); } while (0)
#define PG8_LDA(dst, b, h) do { _Pragma("unroll") for (int m = 0; m < 4; ++m) _Pragma("unroll") for (int k = 0; k < 2; ++k) dst[m][k] = *(const PG8_LAS bf16x8*)(lds + PG8_SA(b, h) + (k ? aoffx : aoff) + m * 2048); } while (0)
#define PG8_LDB(dst, b, h) do { _Pragma("unroll") for (int n = 0; n < 2; ++n) _Pragma("unroll") for (int k = 0; k < 2; ++k) dst[n][k] = *(const PG8_LAS bf16x8*)(lds + PG8_SB(b, h) + (k ? boffx : boff) + n * 2048); } while (0)
#define PG8_MMA(ai, bj, At, Bt) do { __builtin_amdgcn_s_setprio(1); _Pragma("unroll") for (int m = 0; m < 4; ++m) _Pragma("unroll") for (int n = 0; n < 2; ++n) _Pragma("unroll") for (int k = 0; k < 2; ++k) \
        acc[ai][bj][m][n] = __builtin_amdgcn_mfma_f32_16x16x32_bf16(Bt[n][k], At[m][k], acc[ai][bj][m][n], 0, 0, 0); __builtin_amdgcn_s_setprio(0); } while (0)
#define PG8_WAIT_V(n) asm volatile("s_waitcnt vmcnt(" #n ")" ::: "memory")
#define PG8_WAIT_L(n) asm volatile("s_waitcnt lgkmcnt(" #n ")" ::: "memory")
#define PG8_BAR __builtin_amdgcn_s_barrier()
#define PG8_SCHED __builtin_amdgcn_sched_barrier(0)
    Unit cur, nxt; int ui = 0;
    if (!S.next(0, cur)) return;
    f32x4 acc[2][2][4][2];
#pragma unroll
    for (int a = 0; a < 2; ++a)
#pragma unroll
        for (int b = 0; b < 2; ++b)
#pragma unroll
            for (int m = 0; m < 4; ++m)
#pragma unroll
                for (int n = 0; n < 2; ++n) acc[a][b][m][n] = (f32x4){0.f, 0.f, 0.f, 0.f};
    bf16x8 At[4][2], B0[2][2], B1[2][2];
    const char* cA = (const char*)g.A + (size_t)cur.pm * tstepA; const char* cB = (const char*)g.Bt + (size_t)cur.pn * tstepB;
    S.a_ready(cur);
    if constexpr (SP2) {
        PG8_STAGE(PG8_SB(0, 0), cB, voffB); PG8_STAGE(PG8_SB(0, 1), cB + hstepB, voffB); PG8_STAGEA(PG8_SA(0, 0), cA, voffA); PG8_STAGEA(PG8_SA(0, 1), cA + hstepA, voffA);
        if (wr == 1) PG8_BAR;
        PG8_WAIT_V(2); PG8_BAR;
        PG8_STAGE(PG8_SB(1, 0), cB + kstep, voffB); PG8_STAGEA(PG8_SA(1, 0), cA + kstepA, voffA); PG8_STAGE(PG8_SB(1, 1), cB + hstepB + kstep, voffB);
        PG8_WAIT_V(6); PG8_BAR;
    } else {
        PG8_STAGE(PG8_SB(0, 0), cB, voffB); PG8_STAGEA(PG8_SA(0, 0), cA, voffA); PG8_STAGE(PG8_SB(0, 1), cB + hstepB, voffB); PG8_STAGEA(PG8_SA(0, 1), cA + hstepA, voffA);
        if (wr == 1) PG8_BAR;
        PG8_WAIT_V(4); PG8_BAR;
        PG8_STAGE(PG8_SB(1, 0), cB + kstep, voffB); PG8_STAGEA(PG8_SA(1, 0), cA + kstepA, voffA); PG8_STAGE(PG8_SB(1, 1), cB + hstepB + kstep, voffB);
        PG8_WAIT_V(6); PG8_BAR;
    }
    for (;;) {
        const bool has_next = S.next(ui + 1, nxt);
        const char* nA = has_next ? (const char*)g.A + (size_t)nxt.pm * tstepA : cA; const char* nB = has_next ? (const char*)g.Bt + (size_t)nxt.pn * tstepB : cB;
        for (int t = 0; t < nt; t += 2) {
            const bool last = (t == nt - 2);
            const char* a1 = cA + (size_t)(t + 1) * kstepA;
            const char* a2 = last ? nA : cA + (size_t)(t + 2) * kstepA; const char* b2 = last ? nB : cB + (size_t)(t + 2) * kstep;
            const char* a3 = a2 + kstepA; const char* b3 = b2 + kstep;
            if (last && has_next) S.a_ready(nxt);
            if constexpr (SP2) {
            PG8_LDB(B0, 0, 0); PG8_LDB(B1, 0, 1); PG8_SCHED; PG8_LDA(At, 0, 0); PG8_STAGEA(PG8_SA(1, 1), a1 + hstepA, voffA);
            PG8_WAIT_V(8); PG8_WAIT_L(0); PG8_BAR; PG8_MMA(0, 0, At, B0); PG8_MMA(0, 1, At, B1); PG8_BAR; PG8_SCHED;
            PG8_LDA(At, 0, 1); PG8_STAGE(PG8_SB(0, 0), b2, voffB); PG8_STAGE(PG8_SB(0, 1), b2 + hstepB, voffB); PG8_STAGEA(PG8_SA(0, 0), a2, voffA);
            PG8_WAIT_V(8); PG8_WAIT_L(0); PG8_BAR; PG8_MMA(1, 0, At, B0); PG8_MMA(1, 1, At, B1); PG8_BAR; PG8_SCHED;
            PG8_LDB(B0, 1, 0); PG8_LDB(B1, 1, 1); PG8_SCHED; PG8_LDA(At, 1, 0); PG8_STAGEA(PG8_SA(0, 1), a2 + hstepA, voffA);
            PG8_WAIT_V(8); PG8_WAIT_L(0); PG8_BAR; PG8_MMA(0, 0, At, B0); PG8_MMA(0, 1, At, B1); PG8_BAR; PG8_SCHED;
            PG8_LDA(At, 1, 1); PG8_STAGE(PG8_SB(1, 0), b3, voffB); PG8_STAGE(PG8_SB(1, 1), b3 + hstepB, voffB); PG8_STAGEA(PG8_SA(1, 0), a3, voffA);
            PG8_WAIT_V(8); PG8_WAIT_L(0); PG8_BAR; PG8_MMA(1, 0, At, B0); PG8_MMA(1, 1, At, B1); PG8_BAR; PG8_SCHED;
            } else {
            PG8_LDB(B0, 0, 0); PG8_SCHED; PG8_LDA(At, 0, 0); PG8_STAGEA(PG8_SA(1, 1), a1 + hstepA, voffA);
            PG8_WAIT_L(8); PG8_BAR; PG8_WAIT_L(0); PG8_MMA(0, 0, At, B0); PG8_BAR; PG8_SCHED;
            PG8_LDB(B1, 0, 1); PG8_STAGE(PG8_SB(0, 0), b2, voffB);
            PG8_BAR; PG8_WAIT_L(0); PG8_MMA(0, 1, At, B1); PG8_BAR;
            PG8_LDA(At, 0, 1); PG8_STAGEA(PG8_SA(0, 0), a2, voffA);
            PG8_BAR; PG8_WAIT_L(0); PG8_MMA(1, 0, At, B0); PG8_BAR; PG8_SCHED;
            PG8_STAGE(PG8_SB(0, 1), b2 + hstepB, voffB);
            PG8_WAIT_V(6); PG8_BAR; PG8_MMA(1, 1, At, B1); PG8_BAR;
            PG8_LDB(B0, 1, 0); PG8_SCHED; PG8_LDA(At, 1, 0); PG8_STAGEA(PG8_SA(0, 1), a2 + hstepA, voffA);
            PG8_WAIT_L(8); PG8_BAR; PG8_WAIT_L(0); PG8_MMA(0, 0, At, B0); PG8_BAR; PG8_SCHED;
            PG8_LDB(B1, 1, 1); PG8_STAGE(PG8_SB(1, 0), b3, voffB);
            PG8_BAR; PG8_WAIT_L(0); PG8_MMA(0, 1, At, B1); PG8_BAR;
            PG8_LDA(At, 1, 1); PG8_STAGEA(PG8_SA(1, 0), a3, voffA);
            PG8_BAR; PG8_WAIT_L(0); PG8_MMA(1, 0, At, B0); PG8_BAR; PG8_SCHED;
            PG8_STAGE(PG8_SB(1, 1), b3 + hstepB, voffB);
            PG8_WAIT_V(6); PG8_BAR; PG8_MMA(1, 1, At, B1); PG8_BAR;
            }
        }
        if constexpr (ALIGN_EPI) { if (wr == 0) PG8_BAR; }
        if constexpr (!Epi::AFTER_DRAIN) { E(acc, cur, wr, wc, fr, fq); S.done(cur); }
        if (!has_next) break;
#pragma unroll
        for (int a = 0; a < 2; ++a)
#pragma unroll
            for (int b = 0; b < 2; ++b)
#pragma unroll
                for (int m = 0; m < 4; ++m)
#pragma unroll
                    for (int n = 0; n < 2; ++n) acc[a][b][m][n] = (f32x4){0.f, 0.f, 0.f, 0.f};
        cur = nxt; cA = nA; cB = nB; ++ui;
        if constexpr (ALIGN_EPI) { if (wr == 1) PG8_BAR; }
    }
    PG8_WAIT_V(0);
    if constexpr (!ALIGN_EPI) { if (wr == 0) PG8_BAR; }
    PG8_BAR;
    if constexpr (Epi::AFTER_DRAIN) { E.fused(acc, cur, wr, wc, fr, fq, lds, wid, lane); S.done(cur); }
#undef PG8_SA
#undef PG8_SB
#undef PG8_STAGE
#undef PG8_STAGEA
#undef PG8_LDA
#undef PG8_LDB
#undef PG8_MMA
#undef PG8_WAIT_V
#undef PG8_WAIT_L
#undef PG8_BAR
#undef PG8_SCHED
}
}

constexpr int NWAVES = 8;
constexpr int BATCH = 8, SEQ = 4096, DM = 1024, MTOK = BATCH * SEQ;
constexpr int MEM_LEN = 256, MMEM = BATCH * MEM_LEN;
constexpr int W_IN_COLS = 2840, NPROJ = 3072, DFF = 2816;
constexpr int COL_BG = 0, COL_CG = 512, COL_XIN = 1024, COL_Q = 1536, COL_KC = 2048, COL_VC = 2176, COL_KSL = 2304, COL_VSL = 2432, COL_KW = 2560, COL_VW = 2688, COL_GL = 2816;
constexpr float EPS = 1e-6f;
constexpr float LOG2E = 1.4426950408889634f;
constexpr float C2_NSA = 0.125f * LOG2E;
constexpr float C2_X = 0.0625f * LOG2E;

constexpr size_t MiB = 1u << 20;
#if defined(MK_MULTI) && MK_MULTI
constexpr size_t WS_CTL = 0, CTL_ZERO_BYTES = 256 * 1024;
#else
constexpr size_t WS_CTL = 0, CTL_ZERO_BYTES = 256 * 1024;
#endif
constexpr size_t WS_WIN = 2 * MiB, WS_W1KC = 8 * MiB, WS_W1VC = 9 * MiB, WS_W2KC = 10 * MiB, WS_W2VC = 10 * MiB + 512 * 1024;
constexpr size_t WS_WOUT = 11 * MiB, WS_WQ = 13 * MiB, WS_WKV = 15 * MiB, WS_WO = 19 * MiB, WS_WGU = 21 * MiB, WS_WD = 32 * MiB;
constexpr size_t WS_MN = 38 * MiB, WS_KVX = 42 * MiB, WS_KCMP = 50 * MiB, WS_VCMP = 51 * MiB, WS_BPART = 51 * MiB + 512 * 1024, WS_ROPE = 52 * MiB, WS_RSTD = 60 * MiB, WS_SQ = 61 * MiB;
constexpr size_t WS_XN = 64 * MiB, WS_H = WS_XN, WS_PROJ = 128 * MiB, WS_HB = WS_PROJ, WS_MIXED = 320 * MiB, WS_QX = WS_MIXED, WS_Z = 384 * MiB, WS_MBT = 448 * MiB, WS_NBT = 464 * MiB, WS_END = 512 * MiB;
#ifndef HB_PITCH
#define HB_PITCH DFF
#endif
constexpr size_t HB_BATCH_SHIFT = (size_t)SEQ * (NPROJ - HB_PITCH);
constexpr int CW_BAR = 4096;
constexpr int PCNT_STRIDE = 32;
constexpr size_t WS_PCNT = 64 * 1024;
constexpr size_t SQ_BYTES = (size_t)MTOK * 4 * 4;

constexpr int RING_OFF = 0, RING_BYTES = 131072;
constexpr int WSF_OFF = RING_BYTES;
constexpr int LDS_BYTES = 147456;
constexpr int LDSCTL_OFF = LDS_BYTES - 512, MISC_OFF = LDSCTL_OFF + 320;
static_assert(MISC_OFF + 128 <= LDS_BYTES, "LDS map");

#define GAS __attribute__((address_space(1)))
#define LAS __attribute__((address_space(3)))
typedef unsigned short bf16;
typedef unsigned v4u __attribute__((ext_vector_type(4)));
typedef float f32x4 __attribute__((ext_vector_type(4)));
typedef short bf16x8 __attribute__((ext_vector_type(8)));
typedef GAS unsigned gu32;
typedef GAS unsigned long long gu64;
#define RLX_AGENT __ATOMIC_RELAXED, __HIP_MEMORY_SCOPE_AGENT
#define LDS_WAIT() asm volatile("s_waitcnt lgkmcnt(0)" ::: "memory")
#define VM_WAIT() asm volatile("s_waitcnt vmcnt(0)" ::: "memory")
__device__ __forceinline__ unsigned long long rt() { return __builtin_amdgcn_s_memrealtime(); }
__device__ __forceinline__ unsigned f2bf(float f) { unsigned u = __builtin_bit_cast(unsigned, f); return (u + 0x7fffu + ((u >> 16) & 1u)) >> 16; }
__device__ __forceinline__ unsigned pk2(float lo, float hi) { unsigned r; asm("v_cvt_pk_bf16_f32 %0, %1, %2" : "=v"(r) : "v"(lo), "v"(hi)); return r; }
#define XB_TMO      128
#define XB_XCNT(j)  (256  + 64 * (j))
#define XB_XSUB(j)  (1280 + 64 * (j))
#define XB_XGEN(j)  (2304 + 64 * (j))
#define XB_TOP      3328
#define XB_TOPGEN   3392
#define XCD_BAR_WORDS 3456
#define XB_SPIN_CAP (1u << 18)

__device__ __forceinline__ unsigned xb_ld(unsigned* p)              { return __hip_atomic_load(p, __ATOMIC_RELAXED, __HIP_MEMORY_SCOPE_AGENT); }
__device__ __forceinline__ unsigned xb_add(unsigned* p, unsigned v) { return __hip_atomic_fetch_add(p, v, __ATOMIC_RELAXED, __HIP_MEMORY_SCOPE_AGENT); }
__device__ __forceinline__ unsigned xb_xcc_id() { return (unsigned)__builtin_amdgcn_s_getreg((3 << 11) | 20) & 0xFu; }
#define XB_SPIN(cond, bar) do { unsigned _sp = 0; while (cond) { __builtin_amdgcn_s_sleep(1); \
    if ((++_sp & 255u) == 0u) { if (xb_ld(&(bar)[XB_TMO])) break; if (_sp > XB_SPIN_CAP) { atomicAdd(&(bar)[XB_TMO], 1u); break; } } } } while (0)

struct XcdBarrier {
    unsigned* bar; unsigned x;
    volatile LAS unsigned* st;
};

__device__ __forceinline__ XcdBarrier xcd_barrier_post(unsigned* bar, volatile LAS unsigned* st) {
    XcdBarrier b; b.bar = bar; b.x = xb_xcc_id(); b.st = st;
    if (threadIdx.x == 0) st[3] = xb_add(&bar[XB_XCNT(b.x)], 1u);
    return b;
}
__device__ __forceinline__ void xcd_barrier_complete(unsigned* bar, unsigned x, unsigned& nloc, unsigned& nx, unsigned& ok32) {
    const unsigned G = gridDim.x * gridDim.y * gridDim.z;
    unsigned sum, cnt, mine, c32, sp = 0u;
    for (;;) {
        sum = 0u; cnt = 0u; mine = 0u; c32 = 0u;
#pragma unroll
        for (unsigned j = 0; j < 16; ++j) { const unsigned c = xb_ld(&bar[XB_XCNT(j)]); sum += c; cnt += (c > 0u) ? 1u : 0u; c32 += (j < 8u && c == 32u) ? 1u : 0u; mine = (j == x) ? c : mine; }
        if (sum == G) break;
        __builtin_amdgcn_s_sleep(1);
        if ((++sp & 255u) == 0u) { if (xb_ld(&bar[XB_TMO])) break; if (sp > XB_SPIN_CAP) { atomicAdd(&bar[XB_TMO], 1u); break; } }
    }
    nloc = mine > 0u ? mine : 1u; nx = cnt > 0u ? cnt : 1u;
    ok32 = (sum == G && G == 256u && cnt == 8u && c32 == 8u && xb_ld(&bar[XB_TMO]) == 0u) ? 1u : 0u;
}

__device__ __forceinline__ void xcd_barrier(const XcdBarrier& b, bool local = false) {
    asm volatile("s_waitcnt vmcnt(0)" ::: "memory");
    __syncthreads();
    if (threadIdx.x == 0) {
        unsigned* bar = b.bar;
        __builtin_amdgcn_s_waitcnt(0);
        unsigned nloc = b.st[0], nx = b.st[1];
        if (nloc == 0u) { unsigned ok32; xcd_barrier_complete(bar, b.x, nloc, nx, ok32); b.st[0] = nloc; b.st[1] = nx; b.st[2] = ok32; }
        const unsigned old = xb_add(&bar[XB_XSUB(b.x)], 1u);
        const unsigned gen = old / nloc;
        if (old + 1u == (gen + 1u) * nloc) {
          if (!local) {
            __builtin_amdgcn_fence(__ATOMIC_RELEASE, "agent");
            asm volatile("s_waitcnt vmcnt(0)" ::: "memory");
            const unsigned og = xb_add(&bar[XB_TOP], 1u);
            const unsigned tg = og / nx;
            if (og + 1u == (tg + 1u) * nx) xb_add(&bar[XB_TOPGEN], 1u);
            else XB_SPIN(xb_ld(&bar[XB_TOPGEN]) == tg, bar);
          }
            __builtin_amdgcn_fence(__ATOMIC_ACQUIRE, "agent");
            xb_add(&bar[XB_XGEN(b.x)], 1u);
            asm volatile("s_waitcnt vmcnt(0)" ::: "memory");
        } else {
            XB_SPIN(xb_ld(&bar[XB_XGEN(b.x)]) == gen, bar);
            __builtin_amdgcn_fence(__ATOMIC_ACQUIRE, "agent");
            asm volatile("s_waitcnt vmcnt(0)" ::: "memory");
        }
    }
    __syncthreads();
}

typedef float f32x16 __attribute__((ext_vector_type(16)));
typedef short s16x4 __attribute__((ext_vector_type(4)));
typedef float f32x2_t __attribute__((ext_vector_type(2)));
typedef __bf16 bf16x2_t __attribute__((ext_vector_type(2)));
typedef LAS char lchar;
#define SBAR() __builtin_amdgcn_sched_barrier(0)
__device__ __forceinline__ float bf2f(unsigned short h) { return __uint_as_float((unsigned)h << 16); }
__device__ __forceinline__ float bflo(unsigned w) { return __uint_as_float(w << 16); }
__device__ __forceinline__ float bfhi(unsigned w) { return __uint_as_float(w & 0xffff0000u); }
__device__ __forceinline__ unsigned cvtpk(float lo, float hi) { f32x2_t v = {lo, hi}; bf16x2_t b = __builtin_convertvector(v, bf16x2_t); return __builtin_bit_cast(unsigned, b); }
template <int CTRL> __device__ __forceinline__ float dpp_ror(float v) { return __int_as_float(__builtin_amdgcn_update_dpp(0, __float_as_int(v), CTRL, 0xf, 0xf, false)); }
__device__ __forceinline__ float wave_sum(float v) {
    v += dpp_ror<0x128>(v); v += dpp_ror<0x124>(v); v += dpp_ror<0x122>(v); v += dpp_ror<0x121>(v);
    { auto r = __builtin_amdgcn_permlane16_swap(__float_as_uint(v), __float_as_uint(v), false, false); v = __uint_as_float(r[0]) + __uint_as_float(r[1]); }
    { auto r = __builtin_amdgcn_permlane32_swap(__float_as_uint(v), __float_as_uint(v), false, false); v = __uint_as_float(r[0]) + __uint_as_float(r[1]); }
    return v;
}
__device__ __forceinline__ float row16_sum(float v) { v += dpp_ror<0x128>(v); v += dpp_ror<0x124>(v); v += dpp_ror<0x122>(v); v += dpp_ror<0x121>(v); return v; }
__device__ __forceinline__ float rows4_sum(float v) {
    { auto r = __builtin_amdgcn_permlane16_swap(__float_as_uint(v), __float_as_uint(v), false, false); v = __uint_as_float(r[0]) + __uint_as_float(r[1]); }
    { auto r = __builtin_amdgcn_permlane32_swap(__float_as_uint(v), __float_as_uint(v), false, false); v = __uint_as_float(r[0]) + __uint_as_float(r[1]); }
    return v; }
__device__ __forceinline__ float rows4_max(float v) {
    { auto r = __builtin_amdgcn_permlane16_swap(__float_as_uint(v), __float_as_uint(v), false, false); v = fmaxf(__uint_as_float(r[0]), __uint_as_float(r[1])); }
    { auto r = __builtin_amdgcn_permlane32_swap(__float_as_uint(v), __float_as_uint(v), false, false); v = fmaxf(__uint_as_float(r[0]), __uint_as_float(r[1])); }
    return v; }
__device__ __forceinline__ int crow(int r, int hi) { return (r & 3) + 8 * (r >> 2) + 4 * hi; }
__device__ __forceinline__ float pair_max(float a) { auto rr = __builtin_amdgcn_permlane32_swap(__float_as_uint(a), __float_as_uint(a), false, false); return fmaxf(__uint_as_float(rr[0]), __uint_as_float(rr[1])); }
__device__ __forceinline__ float pair_sum(float a) { auto rr = __builtin_amdgcn_permlane32_swap(__float_as_uint(a), __float_as_uint(a), false, false); return __uint_as_float(rr[0]) + __uint_as_float(rr[1]); }
__device__ __forceinline__ f32x16 mfma32(bf16x8 a, bf16x8 b, f32x16 c) { return __builtin_amdgcn_mfma_f32_32x32x16_bf16(a, b, c, 0, 0, 0); }

struct Frame {
    LAS unsigned char* lds;
    volatile LAS unsigned* MISC;
    gu32* ctl;
    int tid, lane, wave;
    int vcu, G;
    int vx, vr;
};
struct Args { const void* in[26]; float* out; unsigned char* ws; int ph_lo, ph_hi, bar_region, pad; };
#define INF(i) ((const float*)A.in[i])
#define WSB(off) ((bf16*)(A.ws + (off)))

namespace ab {
using bf16=__hip_bfloat16;
using u32x4=__attribute__((ext_vector_type(4)))unsigned;
constexpr int PITCH=NPROJ;
constexpr int NW=8,QBLK=32,KVBLK=64;
constexpr int NSLOT=3, SLOTB=8192;
constexpr int LDS_K=0, LDS_V=NSLOT*SLOTB, LDS_WS=2*NSLOT*SLOTB, LDS_END=LDS_WS+NW*64*4;
__device__ __forceinline__ void glds16(const void*sbase_,unsigned voff,unsigned lds_dst){unsigned keep;
  const unsigned long long b_=(unsigned long long)(uintptr_t)sbase_; const unsigned long long sbase=((unsigned long long)(unsigned)__builtin_amdgcn_readfirstlane((int)(unsigned)(b_>>32))<<32)|(unsigned)__builtin_amdgcn_readfirstlane((int)(unsigned)b_);
  asm volatile("s_mov_b32 %0, m0\n\ts_mov_b32 m0, %2\n\ts_nop 0\n\tglobal_load_lds_dwordx4 %1, %3\n\ts_mov_b32 m0, %0":"=&s"(keep):"v"(voff),"s"(lds_dst),"s"(sbase):"memory");}
__device__ __forceinline__ float max3f(float a,float b,float c){float r;asm("v_max3_f32 %0, %1, %2, %3":"=v"(r):"v"(a),"v"(b),"v"(c));return r;}
__device__ __forceinline__ float max2f(float a,float b){float r;asm("v_max_f32_e32 %0, %1, %2":"=v"(r):"v"(a),"v"(b));return r;}
__device__ __forceinline__ float fadd_s(float a,float b){float r;asm("v_add_f32_e32 %0, %1, %2":"=v"(r):"v"(a),"v"(b));return r;}
__device__ __forceinline__ float fsub_s(float a,float b){float r;asm("v_sub_f32_e32 %0, %1, %2":"=v"(r):"v"(a),"v"(b));return r;}
__device__ __forceinline__ unsigned cvtpk_s(float lo,float hi){f32x2_t v={lo,hi};bf16x2_t b=__builtin_convertvector(v,bf16x2_t);return __builtin_bit_cast(unsigned,b);}
#define WAIT_BAR(N) asm volatile("s_waitcnt vmcnt(" #N ") lgkmcnt(0)\n\ts_barrier":::"memory")

__device__ __forceinline__ void qkt(f32x16&p0,f32x16&p1,const char*Kslot,const bf16x8*qr,const f32x16&negm,int r32,int hi){
  const char*kb=Kslot+hi*1024+r32*16;
  #pragma unroll
  for(int d0=0;d0<4;++d0){
    const bf16x8 b0=*reinterpret_cast<const bf16x8*>(kb+d0*2048);
    const bf16x8 b1=*reinterpret_cast<const bf16x8*>(kb+d0*2048+512);
    if(d0==0){p0=__builtin_amdgcn_mfma_f32_32x32x16_bf16(b0,qr[0],negm,0,0,0);p1=__builtin_amdgcn_mfma_f32_32x32x16_bf16(b1,qr[0],negm,0,0,0);}
    else{p0=__builtin_amdgcn_mfma_f32_32x32x16_bf16(b0,qr[d0],p0,0,0,0);p1=__builtin_amdgcn_mfma_f32_32x32x16_bf16(b1,qr[d0],p1,0,0,0);}}
}
typedef __attribute__((address_space(3))) const char* lds_cptr;
typedef short v4i16_t __attribute__((ext_vector_type(4)));
__device__ __forceinline__ void kload8(bf16x8*kf,lds_cptr kp){
  kf[0]=*(const __attribute__((address_space(3))) bf16x8*)(kp);      kf[1]=*(const __attribute__((address_space(3))) bf16x8*)(kp+512);
  kf[2]=*(const __attribute__((address_space(3))) bf16x8*)(kp+2048); kf[3]=*(const __attribute__((address_space(3))) bf16x8*)(kp+2560);
  kf[4]=*(const __attribute__((address_space(3))) bf16x8*)(kp+4096); kf[5]=*(const __attribute__((address_space(3))) bf16x8*)(kp+4608);
  kf[6]=*(const __attribute__((address_space(3))) bf16x8*)(kp+6144); kf[7]=*(const __attribute__((address_space(3))) bf16x8*)(kp+6656);
}
__device__ __forceinline__ void kload2(bf16x8*kf,lds_cptr kp,int j){ kf[2*j]=*(const __attribute__((address_space(3))) bf16x8*)(kp+j*2048); kf[2*j+1]=*(const __attribute__((address_space(3))) bf16x8*)(kp+j*2048+512); }
__device__ __forceinline__ s16x4 vtr(lds_cptr p){ return __builtin_bit_cast(s16x4,__builtin_amdgcn_ds_read_tr16_b64_v4i16((__attribute__((address_space(3))) v4i16_t*)p)); }
__device__ __forceinline__ float rowmax(const f32x16&p0,const f32x16&p1){
  float a=max3f(p0[0],p0[1],p1[0]),b=max3f(p0[2],p0[3],p1[1]);a=max3f(a,p1[2],p1[3]);
  #pragma unroll
  for(int r=4;r<16;r+=4){a=max3f(a,p0[r],p0[r+1]);b=max3f(b,p0[r+2],p0[r+3]);a=max3f(a,p1[r],p1[r+1]);b=max3f(b,p1[r+2],p1[r+3]);}
  const float m=max2f(a,b);
  auto rr=__builtin_amdgcn_permlane32_swap(__float_as_uint(m),__float_as_uint(m),false,false);
  return max2f(__uint_as_float(rr[0]),__uint_as_float(rr[1]));
}
__device__ __forceinline__ void pv(f32x16*o,int vb,bf16x8 pa0,bf16x8 pa1,bf16x8 pa2,bf16x8 pa3){
  #pragma unroll
  for(int d0=0;d0<2;++d0){s16x4 lo[4],hi[4];
    #pragma unroll
    for(int ks=0;ks<4;++ks){
      asm volatile("ds_read_b64_tr_b16 %0,%1 offset:%c2":"=&v"(lo[ks]):"v"(vb),"i"(d0*4096+ks*1024):"memory");
      asm volatile("ds_read_b64_tr_b16 %0,%1 offset:%c2":"=&v"(hi[ks]):"v"(vb),"i"(d0*4096+ks*1024+512):"memory");}
    asm volatile("s_waitcnt lgkmcnt(0)":::"memory");SBAR();
    #define PK(k) (bf16x8){lo[k][0],lo[k][1],lo[k][2],lo[k][3],hi[k][0],hi[k][1],hi[k][2],hi[k][3]}
    o[d0]=__builtin_amdgcn_mfma_f32_32x32x16_bf16(pa0,PK(0),o[d0],0,0,0);
    o[d0]=__builtin_amdgcn_mfma_f32_32x32x16_bf16(pa1,PK(1),o[d0],0,0,0);
    o[d0]=__builtin_amdgcn_mfma_f32_32x32x16_bf16(pa2,PK(2),o[d0],0,0,0);
    o[d0]=__builtin_amdgcn_mfma_f32_32x32x16_bf16(pa3,PK(3),o[d0],0,0,0);
    #undef PK
  }
}

__device__ __forceinline__ void attn_stream_issue(const bf16*__restrict__ Kh,const bf16*__restrict__ Vh,int t_lo,int nT,char*shm,int lane_in){
  const int lane=lane_in; const int wid=__builtin_amdgcn_readfirstlane((int)threadIdx.x>>6);
  const unsigned lds0=(unsigned)(uintptr_t)shm;
  const unsigned koff=(unsigned)(lane*PITCH+wid*8)*2u, voff=(unsigned)((16*(wid&3)+(lane>>2))*PITCH+(wid>>2)*32+(lane&3)*8)*2u;
  const unsigned kdst=lds0+LDS_K+wid*1024, vdst=lds0+LDS_V+wid*1024;
  #define TACT(t) (t_lo+((t)<nT?(t):nT-1))
  glds16(Kh+(long)TACT(0)*KVBLK*PITCH,koff,(unsigned)__builtin_amdgcn_readfirstlane(kdst));
  glds16(Vh+(long)TACT(0)*KVBLK*PITCH,voff,(unsigned)__builtin_amdgcn_readfirstlane(vdst));
  glds16(Kh+(long)TACT(1)*KVBLK*PITCH,koff,(unsigned)__builtin_amdgcn_readfirstlane(kdst+SLOTB));
  glds16(Kh+(long)TACT(2)*KVBLK*PITCH,koff,(unsigned)__builtin_amdgcn_readfirstlane(kdst+2*SLOTB));
  #undef TACT
}
template<int THRL,class Mask,bool PRE_ISSUED=false> __device__ __forceinline__ void attn_stream(const bf16*__restrict__ Kh,const bf16*__restrict__ Vh,int t_lo,int nT,const bf16x8*qr,const Mask&mask,char*shm,f32x16*o,float&l_out,int lane_in){
  const int lane=lane_in,r32=lane&31,hi=lane>>5; const int wid=__builtin_amdgcn_readfirstlane((int)threadIdx.x>>6);
  const unsigned lds0=(unsigned)(uintptr_t)shm;
  float*wsf=(float*)(shm+LDS_WS)+wid*64;
  const unsigned koff=(unsigned)(lane*PITCH+wid*8)*2u, voff=(unsigned)((16*(wid&3)+(lane>>2))*PITCH+(wid>>2)*32+(lane&3)*8)*2u;
  const unsigned kdst=lds0+LDS_K+wid*1024, vdst=lds0+LDS_V+wid*1024;
  #define TACT(t) (t_lo+((t)<nT?(t):nT-1))
  #define DMA_K(t,slot) glds16(Kh+(long)TACT(t)*KVBLK*PITCH,koff,(unsigned)__builtin_amdgcn_readfirstlane(kdst+(slot)))
  #define DMA_V(t,slot) glds16(Vh+(long)TACT(t)*KVBLK*PITCH,voff,(unsigned)__builtin_amdgcn_readfirstlane(vdst+(slot)))
  const int vb0=(int)(lds0+LDS_V)+((lane>>4)&1)*32+(lane&3)*8+(4*hi+((lane&15)>>2))*64;
  const char*Kbase=shm+LDS_K; bf16x8 kf[8];
  const lds_cptr shm3=(lds_cptr)shm; const lds_cptr kp0=shm3+LDS_K+hi*1024+r32*16; const lds_cptr vp0=shm3+LDS_V+((lane>>4)&1)*32+(lane&3)*8+(4*hi+((lane&15)>>2))*64;
  const int NT=nT<=4?4:nT;
  if(!PRE_ISSUED){DMA_K(0,0);DMA_V(0,0);DMA_K(1,SLOTB);}
  float mhat=0.f,l_reg=0.f;o[0]=f32x16{};o[1]=f32x16{};f32x16 negm=f32x16{};asm volatile("":"+v"(negm));
#ifdef X_NOMASK
  #define CMASK(P0,P1,t) do{}while(0)
#else
  #define CMASK(P0,P1,t) mask(P0,P1,(t),hi)
#endif
  bool resc=false;
  #define START(P0,P1) do{ const float rm=rowmax(P0,P1); resc=false; \
    { const float dl=(rm==-INFINITY)?0.f:rm; mhat=fadd_s(mhat,dl); \
      _Pragma("unroll") for(int r=0;r<16;++r){P0[r]=fsub_s(P0[r],dl);P1[r]=fsub_s(P1[r],dl);} \
      _Pragma("unroll") for(int r=0;r<16;++r)negm[r]=-mhat; asm volatile("":"+v"(negm)); } \
    _Pragma("unroll") for(int r=0;r<16;++r)P0[r]=__builtin_amdgcn_exp2f(P0[r]); }while(0)
  #define RESC() do{ if(resc){ asm volatile("s_waitcnt lgkmcnt(0)":::"memory"); \
      _Pragma("unroll") for(int d_=0;d_<2;++d_) _Pragma("unroll") for(int r=0;r<16;++r)o[d_][r]*=wsf[crow(r,hi)]; } }while(0)
  f32x16 pA0,pA1,pB0,pB1;
  int sl_prev=0,sl_cur=0,sl_next=SLOTB;
  #define ROT() do{sl_prev=sl_cur;sl_cur=sl_next;sl_next=(sl_next==(NSLOT-1)*SLOTB)?0:sl_next+SLOTB;}while(0)
  if(!PRE_ISSUED){DMA_K(2,2*SLOTB);}
  WAIT_BAR(3);
  qkt(pA0,pA1,Kbase,qr,negm,r32,hi);asm volatile("s_nop 15\n\ts_nop 7":"+v"(pA0),"+v"(pA1));CMASK(pA0,pA1,0);
  START(pA0,pA1);
  _Pragma("unroll") for(int r=0;r<16;++r)pA1[r]=__builtin_amdgcn_exp2f(pA1[r]);
  WAIT_BAR(0);
  DMA_K(3,0);DMA_V(1,SLOTB);
  ROT();
  kload8(kf,kp0+sl_cur);
  WAIT_BAR(2);
  s16x4 vlo[8],vhi[8]; u32x4 pw0,pw1,pw2,pw3;
  #define PKW(P,B) cvtpk_s(P[B],P[B+1])
  #define PAF(k) __builtin_bit_cast(bf16x8,pw##k)
  #define VFR(i) (bf16x8){vlo[i][0],vlo[i][1],vlo[i][2],vlo[i][3],vhi[i][0],vhi[i][1],vhi[i][2],vhi[i][3]}
  #define PIN(x) asm volatile("":"+v"(x))
  #define MX3(a,b,c) __builtin_fmaxf(__builtin_fmaxf((a),(b)),(c))
  #define GAPA(MF,A0,A1,A2,A3,W0,W1,PW) do{ MF; sacc+=A0; sacc+=A1; sacc+=A2; sacc+=A3; PIN(sacc); W0; W1; PIN(PW); SBAR(); }while(0)
  #define EX(v) __builtin_amdgcn_exp2f(v)
  #define GAPB(MF,X,B) do{ MF; X[B]=EX(X[B]); X[B+1]=EX(X[B+1]); X[B+2]=EX(X[B+2]); X[B+3]=EX(X[B+3]); PIN(X); SBAR(); }while(0)
  #define VRD(i) do{ vlo[i]=vtr(vp_+(((i)>>2)*4096+((i)&3)*1024)); vhi[i]=vtr(vp_+(((i)>>2)*4096+((i)&3)*1024+512)); }while(0)
  #define KRD(G,j) do{ if(G){ kload2(kf,kp0+sl_next,j); SBAR(); } }while(0)
  #define STEP(C0,C1,P0,P1,t,GK,GV,GL) do{ SBAR(); \
    const lds_cptr vp_=vp0+sl_prev; \
    VRD(0); SBAR(); float sacc=(P0[0]+P0[1]); \
    GAPA(C0=__builtin_amdgcn_mfma_f32_32x32x16_bf16(kf[0],qr[0],negm,0,0,0), P0[2],P0[3],P0[4],P0[5],     pw0[0]=PKW(P0,0), pw0[1]=PKW(P0,2), pw0); \
    VRD(4); SBAR(); GAPA(C1=__builtin_amdgcn_mfma_f32_32x32x16_bf16(kf[1],qr[0],negm,0,0,0), P0[6],P0[7],P0[8],P0[9],     pw0[2]=PKW(P0,4), pw0[3]=PKW(P0,6), pw0); \
    VRD(1); SBAR(); GAPA(C0=__builtin_amdgcn_mfma_f32_32x32x16_bf16(kf[2],qr[1],C0,0,0,0),   P0[10],P0[11],P0[12],P0[13], pw1[0]=PKW(P0,8), pw1[1]=PKW(P0,10), pw1); \
    VRD(5); SBAR(); GAPA(C1=__builtin_amdgcn_mfma_f32_32x32x16_bf16(kf[3],qr[1],C1,0,0,0),   P0[14],P0[15],P1[0],P1[1],   pw1[2]=PKW(P0,12),pw1[3]=PKW(P0,14), pw1); \
    VRD(2); SBAR(); GAPA(C0=__builtin_amdgcn_mfma_f32_32x32x16_bf16(kf[4],qr[2],C0,0,0,0),   P1[2],P1[3],P1[4],P1[5],     pw2[0]=PKW(P1,0), pw2[1]=PKW(P1,2), pw2); \
    VRD(6); SBAR(); GAPA(C1=__builtin_amdgcn_mfma_f32_32x32x16_bf16(kf[5],qr[2],C1,0,0,0),   P1[6],P1[7],P1[8],P1[9],     pw2[2]=PKW(P1,4), pw2[3]=PKW(P1,6), pw2); \
    VRD(3); SBAR(); GAPA(C0=__builtin_amdgcn_mfma_f32_32x32x16_bf16(kf[6],qr[3],C0,0,0,0),   P1[10],P1[11],P1[12],P1[13], pw3[0]=PKW(P1,8), pw3[1]=PKW(P1,10), pw3); \
    VRD(7); SBAR(); GAPA(C1=__builtin_amdgcn_mfma_f32_32x32x16_bf16(kf[7],qr[3],C1,0,0,0),   P1[14],P1[15],0.f,0.f,       pw3[2]=PKW(P1,12),pw3[3]=PKW(P1,14), pw3); \
    l_reg+=sacc; \
    if(GK){DMA_K((t)+3,sl_cur);} if(GV){DMA_V((t)+1,sl_next);} \
    CMASK(C0,C1,t); \
    { float a=MX3(C0[0],C0[1],C1[0]),b=MX3(C0[2],C0[3],C1[1]); a=MX3(a,C1[2],C1[3]); \
      _Pragma("unroll") for(int r=4;r<16;r+=4){a=MX3(a,C0[r],C0[r+1]);b=MX3(b,C0[r+2],C0[r+3]);a=MX3(a,C1[r],C1[r+1]);b=MX3(b,C1[r+2],C1[r+3]);} \
      float rm=__builtin_fmaxf(a,b); { auto rr=__builtin_amdgcn_permlane32_swap(__float_as_uint(rm),__float_as_uint(rm),false,false); rm=__builtin_fmaxf(__uint_as_float(rr[0]),__uint_as_float(rr[1])); } \
      resc=false; \
      if(__builtin_expect(__any(rm>(float)THRL),0)){ const float dl=__builtin_fmaxf(rm,0.f); mhat+=dl; \
        _Pragma("unroll") for(int r=0;r<16;++r){C0[r]-=dl;C1[r]-=dl;} \
        _Pragma("unroll") for(int r=0;r<16;++r)negm[r]=-mhat; asm volatile("":"+v"(negm)); \
        const float f=__builtin_amdgcn_exp2f(-dl); l_reg*=f; if(hi==0)wsf[r32]=f; resc=true; } } \
    SBAR(); \
    GAPB(o[0]=__builtin_amdgcn_mfma_f32_32x32x16_bf16(PAF(0),VFR(0),o[0],0,0,0), C0,0); \
    GAPB(o[1]=__builtin_amdgcn_mfma_f32_32x32x16_bf16(PAF(0),VFR(4),o[1],0,0,0), C0,4); \
    KRD(GL,0); GAPB(o[0]=__builtin_amdgcn_mfma_f32_32x32x16_bf16(PAF(1),VFR(1),o[0],0,0,0), C0,8); \
    KRD(GL,1); GAPB(o[1]=__builtin_amdgcn_mfma_f32_32x32x16_bf16(PAF(1),VFR(5),o[1],0,0,0), C0,12); \
    KRD(GL,2); GAPB(o[0]=__builtin_amdgcn_mfma_f32_32x32x16_bf16(PAF(2),VFR(2),o[0],0,0,0), C1,0); \
    KRD(GL,3); GAPB(o[1]=__builtin_amdgcn_mfma_f32_32x32x16_bf16(PAF(2),VFR(6),o[1],0,0,0), C1,4); \
    GAPB(o[0]=__builtin_amdgcn_mfma_f32_32x32x16_bf16(PAF(3),VFR(3),o[0],0,0,0), C1,8); \
    GAPB(o[1]=__builtin_amdgcn_mfma_f32_32x32x16_bf16(PAF(3),VFR(7),o[1],0,0,0), C1,12); \
    }while(0)
  int t=1;
  for(;t+5<NT;t+=2){
    STEP(pB0,pB1,pA0,pA1,t,true,true,true);     WAIT_BAR(2); RESC(); ROT();
    STEP(pA0,pA1,pB0,pB1,t+1,true,true,true);   WAIT_BAR(2); RESC(); ROT();
  }
  #define ENDW(tt) do{ if((tt)+3<NT){WAIT_BAR(2);} else if((tt)+2<NT){WAIT_BAR(1);} else {WAIT_BAR(0);} }while(0)
  for(;t+1<NT;t+=2){
    STEP(pB0,pB1,pA0,pA1,t,(t+3<NT),(t+1<NT),(t+1<NT));       ENDW(t);   RESC(); ROT();
    STEP(pA0,pA1,pB0,pB1,t+1,(t+4<NT),(t+2<NT),(t+2<NT));     ENDW(t+1); RESC(); if(t+2<NT){ROT();}
  }
  #define DRAIN(Q0,Q1,SL) do{ float sacc=Q0[0]+Q0[1]; _Pragma("unroll") for(int r=2;r<16;++r)sacc+=Q0[r]; _Pragma("unroll") for(int r=0;r<16;++r)sacc+=Q1[r]; l_reg+=sacc; \
    pw0=(u32x4){PKW(Q0,0),PKW(Q0,2),PKW(Q0,4),PKW(Q0,6)};pw1=(u32x4){PKW(Q0,8),PKW(Q0,10),PKW(Q0,12),PKW(Q0,14)};pw2=(u32x4){PKW(Q1,0),PKW(Q1,2),PKW(Q1,4),PKW(Q1,6)};pw3=(u32x4){PKW(Q1,8),PKW(Q1,10),PKW(Q1,12),PKW(Q1,14)}; \
    SBAR(); pv(o,vb0+(SL),PAF(0),PAF(1),PAF(2),PAF(3)); }while(0)
  if(NT&1){ pB0=pA0; pB1=pA1; }
  else{ STEP(pB0,pB1,pA0,pA1,NT-1,false,false,false); RESC(); }
  DRAIN(pB0,pB1,sl_cur);
  #undef DRAIN
  #undef PKW
  #undef PAF
  #undef VFR
  #undef PIN
  #undef MX3
  #undef GAPA
  #undef GAPB
  #undef EX
  #undef VRD
  #undef KRD
  #undef STEP
  #undef ENDW
  {auto rr=__builtin_amdgcn_permlane32_swap(__float_as_uint(l_reg),__float_as_uint(l_reg),false,false);l_reg=__uint_as_float(rr[0])+__uint_as_float(rr[1]);}
  l_out=l_reg;
  asm volatile("s_waitcnt lgkmcnt(0)\n\ts_barrier":::"memory");
  #undef DMA_K
  #undef TACT
  #undef DMA_V
  #undef CMASK
  #undef START
  #undef RESC
  #undef ROT
}

#undef WAIT_BAR
}
template <bool FRAG = false>
__device__ __forceinline__ void p0_transpose_item(const float* W, int K, int ldw, int nsrc, bf16* WT, int drow0, int scol0, int k0, LAS float* scr, int lane, const float* gk = nullptr) {
    const int sc = scol0 + (lane & 31); const bool ok = sc < nsrc;
    float tv[32];
#pragma unroll
    for (int i = 0; i < 32; ++i) { const int kk = 2 * i + (lane >> 5); tv[i] = ok ? __builtin_nontemporal_load(W + (size_t)(k0 + kk) * ldw + sc) : 0.f; if (gk) tv[i] *= gk[k0 + kk]; }
#pragma unroll
    for (int i = 0; i < 32; ++i) { const int kk = 2 * i + (lane >> 5); scr[kk * 33 + (lane & 31)] = tv[i]; }
    LDS_WAIT(); asm volatile("" ::: "memory");
    const int c = lane & 7;
#pragma unroll
    for (int j = 0; j < 4; ++j) { const int n = (lane >> 3) + 8 * j; const LAS float* s = scr + (8 * c) * 33 + n;
        v4u o; o.x = pk2(s[0 * 33], s[1 * 33]); o.y = pk2(s[2 * 33], s[3 * 33]); o.z = pk2(s[4 * 33], s[5 * 33]); o.w = pk2(s[6 * 33], s[7 * 33]);
        if (FRAG) { const int row = drow0 + n, k = k0 + 8 * c; *(GAS v4u*)(WT + ((size_t)((row >> 5) * 128 + (k >> 4)) * 64 + ((k >> 3) & 1) * 32 + (row & 31)) * 8) = o; }
        else *(GAS v4u*)(WT + (size_t)(drow0 + n) * K + k0 + 8 * c) = o; }
    LDS_WAIT(); asm volatile("" ::: "memory");
}
template <bool TILEPERM, bool FRAG = false>
__device__ __forceinline__ void p0_plain(const float* W, int K, int nsrc, int ndest, bf16* WT, int item, LAS float* scr, int lane, const float* gk = nullptr) {
    const int nblk = ndest / 32, kb = item / nblk, nb = item % nblk, n0 = 32 * nb;
    const int scol0 = TILEPERM ? (n0 & ~255) + 64 * ((n0 >> 5) & 3) + 32 * ((n0 >> 7) & 1) : n0;
    p0_transpose_item<FRAG>(W, K, nsrc, nsrc, WT, n0, scol0, 64 * kb, scr, lane, gk);
}
template <int NR>
__device__ __forceinline__ void rms_rows_to_bf16(const float* x, const float* g, bf16* o, int m0, int rstride, int mlim, int lane, float* rs = nullptr) {
    f32x4 v[NR][4];
#pragma unroll
    for (int r = 0; r < NR; ++r) { const int m = m0 + r * rstride; const GAS f32x4* xr = (const GAS f32x4*)(x + (size_t)(m < mlim ? m : m0) * DM) + lane;
#pragma unroll
        for (int j = 0; j < 4; ++j) v[r][j] = __builtin_nontemporal_load(xr + 64 * j); }
    f32x4 gg[4];
#pragma unroll
    for (int j = 0; j < 4; ++j) gg[j] = g ? ((const GAS f32x4*)g + lane)[64 * j] : (f32x4){1.f, 1.f, 1.f, 1.f};
#pragma unroll
    for (int r = 0; r < NR; ++r) { const int m = m0 + r * rstride; float s2 = 0.f;
#pragma unroll
        for (int j = 0; j < 4; ++j) s2 += (v[r][j].x * v[r][j].x + v[r][j].y * v[r][j].y) + (v[r][j].z * v[r][j].z + v[r][j].w * v[r][j].w);
        const float rstd = __builtin_amdgcn_rsqf(wave_sum(s2) * (1.f / DM) + EPS);
        if (m < mlim) { GAS unsigned long long* o8 = (GAS unsigned long long*)(o + (size_t)m * DM) + lane;
#pragma unroll
            for (int j = 0; j < 4; ++j) { const f32x4 y = v[r][j] * rstd * gg[j]; o8[64 * j] = (unsigned long long)pk2(y.x, y.y) | ((unsigned long long)pk2(y.z, y.w) << 32); }
            if (rs && lane == 0) rs[m] = rstd; } }
}
template <bool FRAG>
__device__ __forceinline__ void p0_wg_item(const Frame& F, const float* W, int K, int ldw, int nsrc, bf16* WT, int N0, int scol, int k0, const float* gk, LAS unsigned char* T) {
    const int w = F.wave, lane = F.lane; const bool ok = scol < nsrc;
    f32x4 v[8];
#pragma unroll
    for (int i = 0; i < 8; ++i) { const int k = k0 + 8 * w + i; v[i] = ok ? __builtin_nontemporal_load((const GAS f32x4*)(W + (size_t)k * ldw + scol)) : (f32x4){0.f, 0.f, 0.f, 0.f}; if (gk) v[i] *= gk[k]; }
    LAS unsigned char* tw = T + (32 * (lane >> 3) + 4 * (lane & 7)) * 144 + w * 16;
#pragma unroll
    for (int j = 0; j < 4; ++j) { v4u g; g.x = pk2(v[0][j], v[1][j]); g.y = pk2(v[2][j], v[3][j]); g.z = pk2(v[4][j], v[5][j]); g.w = pk2(v[6][j], v[7][j]); *(LAS v4u*)(tw + j * 144) = g; }
    __syncthreads();
#pragma unroll
    for (int i4 = 0; i4 < 4; ++i4) { const int n = 32 * w + 8 * i4 + (lane >> 3), c = lane & 7; const v4u g = *(const LAS v4u*)(T + n * 144 + c * 16);
        const int row = N0 + n, k = k0 + 8 * c;
        if (FRAG) *(GAS v4u*)(WT + ((size_t)((row >> 5) * 128 + (k >> 4)) * 64 + ((k >> 3) & 1) * 32 + (row & 31)) * 8) = g;
        else *(GAS v4u*)(WT + (size_t)row * K + k) = g; }
}
__device__ __forceinline__ void p0_prologue(Frame& F, const Args& A) {
    LAS float* scr = (LAS float*)(F.lds + RING_OFF + F.wave * 16384);
    const int gw = F.vcu * NWAVES + F.wave, NGW = F.G * NWAVES, lane = F.lane;
    { constexpr int J_IN = 16 * (NPROJ / 256), J_W1 = 32, J_SQ = 16 * 4, J_KV = 16 * 8, J_GU = 16 * (2 * DFF / 256), J_D = (DFF / 64) * 4;
      constexpr int NJ = J_IN + 2 * J_W1 + 2 * J_SQ + J_KV + J_GU + J_D;
      const int lane8 = 32 * (lane >> 3), l4 = 4 * (lane & 7); int par = 0;
      LAS unsigned char* Tb = F.lds + RING_OFF;
#define TPERM(n0) (((n0) & ~255) + 64 * (((n0) >> 5) & 3) + 32 * (((n0) >> 7) & 1))
#if defined(PROBE_DUP) && PROBE_DUP == 20
      for (int rep_ = 0; rep_ < 2; ++rep_)
#endif
      for (int it = F.vcu; it < NJ; it += F.G, par ^= 1) {
          LAS unsigned char* T = Tb + par * 36864; int r = it;
          if (r < J_IN) {
              constexpr int nb = NPROJ / 256; const int kb = r / nb, N0 = 256 * (r % nb), n0 = N0 + lane8, Tl = n0 >> 8, rl = n0 & 255;
              const int sc0 = (Tl >= 2 && Tl < 6) ? (rl < 128 ? COL_CG : COL_XIN - 128) + 128 * (Tl - 2) + rl : TPERM(n0);
              p0_wg_item<false>(F, INF(4), DM, W_IN_COLS, W_IN_COLS, WSB(WS_WIN), N0, sc0 + l4, 64 * kb, INF(3), T); continue; } r -= J_IN;
          if (r < 2 * J_W1) { const int mat = r / J_W1, kb = r % J_W1;
              p0_wg_item<true>(F, mat ? INF(10) : INF(7), 2048, 256, 256, mat ? WSB(WS_W1VC) : WSB(WS_W1KC), 0, lane8 + l4, 64 * kb, nullptr, T); continue; } r -= 2 * J_W1;
          if (r < 2 * J_SQ) { const int mat = r / J_SQ, q = r % J_SQ, kb = q / 4, N0 = 256 * (q % 4);
              p0_wg_item<false>(F, mat ? INF(20) : INF(14), DM, DM, DM, mat ? WSB(WS_WO) : WSB(WS_WOUT), N0, TPERM(N0 + lane8) + l4, 64 * kb, nullptr, T); continue; } r -= 2 * J_SQ;
          if (r < J_KV) { const int kb = r / 8, N0 = 256 * (r % 8);
              p0_wg_item<false>(F, INF(19), DM, 2 * DM, 2 * DM, WSB(WS_WKV), N0, TPERM(N0 + lane8) + l4, 64 * kb, nullptr, T); continue; } r -= J_KV;
          if (r < J_GU) {
              constexpr int nb = 2 * DFF / 256; const int kb = r / nb, pn = r % nb, rl = lane8;
              const int sc0 = rl < 128 ? 128 * pn + rl : DFF + 128 * pn + (rl - 128);
              p0_wg_item<false>(F, INF(23), DM, 2 * DFF, 2 * DFF, WSB(WS_WGU), 256 * pn, sc0 + l4, 64 * kb, INF(22), T); continue; } r -= J_GU;
          { const int kb = r / 4, N0 = 256 * (r % 4);
            p0_wg_item<false>(F, INF(24), DFF, DM, DM, WSB(WS_WD), N0, TPERM(N0 + lane8) + l4, 64 * kb, nullptr, T); }
      }
#undef TPERM
      __syncthreads(); }
    constexpr int I_W2 = 4 * 2, I_SQ = 16 * 32;
#if defined(PROBE_DUP) && PROBE_DUP == 25
    for (int rep_ = 0; rep_ < 2; ++rep_)
#endif
    for (int it = gw; it < 2 * I_W2 + I_SQ; it += NGW) {
        int r = it;
        if (r < I_W2) { p0_plain<false>(INF(8), 256, 64, 64, WSB(WS_W2KC), r, scr, lane); continue; } r -= I_W2;
        if (r < I_W2) { p0_plain<false>(INF(11), 256, 64, 64, WSB(WS_W2VC), r, scr, lane); continue; } r -= I_W2;
        {
#pragma unroll
            for (int j = 0; j < 2; ++j) { const int dr = 2 * r + j, t = dr & 255, sr = (dr & ~255) + 64 * ((t >> 5) & 3) + 32 * ((t >> 7) & 1) + (t & 31); const float gk = INF(16)[sr];
                const GAS f32x4* wr_ = (const GAS f32x4*)(INF(18) + (size_t)sr * DM) + lane; GAS unsigned long long* o8 = (GAS unsigned long long*)(WSB(WS_WQ) + (size_t)dr * DM) + lane;
#pragma unroll
                for (int q4 = 0; q4 < 4; ++q4) { const f32x4 v = __builtin_nontemporal_load(wr_ + 64 * q4) * gk; o8[64 * q4] = (unsigned long long)pk2(v.x, v.y) | ((unsigned long long)pk2(v.z, v.w) << 32); } }
        }
    }
#if defined(PROBE_DUP) && PROBE_DUP == 22
    for (int rep_ = 0; rep_ < 2; ++rep_)
#endif
    if ((gw & 15) == 0 && (gw >> 4) < 128) {
        const int t = gw >> 4, mat = t >> 6, kc = (t >> 2) & 15, cg = t & 3; const float* w1 = (mat ? INF(10) : INF(7)) + (size_t)(128 * kc) * 256 + 64 * cg + lane; const float* pe = (mat ? INF(9) : INF(6)) + 128 * kc;
        float s0 = 0.f, s1 = 0.f;
#pragma unroll 32
        for (int j = 0; j < 128; j += 2) { s0 += pe[j] * w1[(size_t)j * 256]; s1 += pe[j + 1] * w1[(size_t)(j + 1) * 256]; }
        ((float*)(A.ws + WS_BPART))[(mat * 16 + kc) * 256 + 64 * cg + lane] = s0 + s1;
    }
#if defined(PROBE_DUP) && PROBE_DUP == 23
    for (int rep_ = 0; rep_ < 2; ++rep_)
#endif
    { float* rt_ = (float*)(A.ws + WS_ROPE); const int f = lane & 31; const float inv = powf(10000.0f, -(float)f / 32.0f);
      for (int p = gw * 2 + (lane >> 5); p < MTOK; p += NGW * 2) { const float ang = (float)((const int*)A.in[2])[p] * inv; const float tr = __builtin_amdgcn_fractf(ang * 0.15915494309189535f);
          rt_[(size_t)p * 64 + f] = __builtin_amdgcn_cosf(tr); rt_[(size_t)p * 64 + 32 + f] = __builtin_amdgcn_sinf(tr); } }
#if defined(PROBE_DUP) && PROBE_DUP == 21
    for (int rep_ = 0; rep_ < 2; ++rep_)
#endif
    for (int m = gw; m < MTOK; m += 4 * NGW) rms_rows_to_bf16<4>(INF(0), nullptr, WSB(WS_XN), m, NGW, MTOK, lane, (float*)(A.ws + WS_RSTD));
    for (int m = gw; m < MMEM; m += NGW) rms_rows_to_bf16<1>(INF(1), INF(17), WSB(WS_MN), m, NGW, MMEM, lane);
}

__device__ __forceinline__ void p2_rope(Frame& F, const Args& A, int ridx, int nrb) {
    const bool xal = (F.G == 256); const int NGW = xal ? nrb * NWAVES : F.G * NWAVES, gw = xal ? (F.vx * SEQ + ridx * NWAVES + F.wave) : (F.vcu * NWAVES + F.wave), lane = F.lane, f = lane & 31, sh = lane >> 5;
    const int MTOKX = xal ? F.vx * SEQ + SEQ : MTOK;
    const float* tbl = (const float*)(A.ws + WS_ROPE);
    const int c0 = (sh ? COL_KW : COL_KSL) + f;
    for (int tok = gw; tok < MTOKX; tok += 4 * NGW) {
        float cs[4], sn[4], x1[4][2], x2[4][2];
#pragma unroll
        for (int j = 0; j < 4; ++j) { const int tk = tok + j * NGW; if (tk < MTOKX) { cs[j] = tbl[(size_t)tk * 64 + f]; sn[j] = tbl[(size_t)tk * 64 + 32 + f]; const bf16* row = WSB(WS_PROJ) + (size_t)tk * NPROJ + c0;
#pragma unroll
            for (int i = 0; i < 2; ++i) { x1[j][i] = bf2f(row[64 * i]); x2[j][i] = bf2f(row[64 * i + 32]); } } }
#pragma unroll
        for (int j = 0; j < 4; ++j) { const int tk = tok + j * NGW; if (tk < MTOKX) { bf16* row = WSB(WS_PROJ) + (size_t)tk * NPROJ + c0;
#pragma unroll
            for (int i = 0; i < 2; ++i) { row[64 * i] = (bf16)f2bf(x1[j][i] * cs[j] - x2[j][i] * sn[j]); row[64 * i + 32] = (bf16)f2bf(x2[j][i] * cs[j] + x1[j][i] * sn[j]); } } }
    }
}
constexpr int HS_PITCH = 264, CA_RP = 66, CA_CS = 16 * CA_RP + 2  , CA_TOK = 16 * CA_RP, CA_BYTES = 8 * CA_CS * 16;
static_assert(CA_BYTES <= LDSCTL_OFF, "compress LDS image");
__device__ __forceinline__ void compress_unit(Frame& F, const Args& A, int u) {
    const int kv = u & 1, slab = (u >> 1) & 3, bgi = u >> 3, b = bgi >> 1, g = bgi & 1;
    const int lane = F.lane, w = F.wave, tid = F.tid, r32 = lane & 31, hi = lane >> 5;
    const bf16* W1t = kv ? WSB(WS_W1VC) : WSB(WS_W1KC); const bf16* W2t = kv ? WSB(WS_W2VC) : WSB(WS_W2KC);
    lchar* aimg = (lchar*)(F.lds + RING_OFF);
    { const bf16* base = WSB(WS_PROJ) + (size_t)(b * SEQ + 1024 * slab) * NPROJ + (kv ? COL_VC : COL_KC) + g * 64;
      const int chunk = tid & 7;
#pragma unroll
      for (int h = 0; h < 2; ++h) {
          v4u tmp[9];
#pragma unroll
          for (int j = 0; j < 9; ++j) { const int nt_ = (tid >> 3) + 64 * (9 * h + j); const int nn = nt_ < CA_TOK ? nt_ : CA_TOK - 1; const int lp = nn / CA_RP, rp = nn - lp * CA_RP;
              tmp[j] = *(const GAS v4u*)(base + (size_t)(16 * rp + lp) * NPROJ + chunk * 8); }
#pragma unroll
          for (int j = 0; j < 9; ++j) { const int nt_ = (tid >> 3) + 64 * (9 * h + j); if (nt_ < CA_TOK) *(LAS v4u*)(aimg + (chunk * CA_CS + nt_) * 16) = tmp[j]; } } }
    __syncthreads();
    const bf16* wsrc = W1t + ((size_t)(w * 128) * 64 + lane) * 8;
    const lchar* ard = aimg + (hi * CA_CS + r32) * 16;
    f32x16 acc[2]; acc[0] = (f32x16){}; acc[1] = (f32x16){};
#pragma unroll 32
    for (int ks = 0; ks < 128; ++ks) {
        const int l = ks >> 2, d0 = ks & 3; const int off = (2 * d0 * CA_CS + (l & 15) * CA_RP + (l >> 4)) * 16;
        const bf16x8 a0 = *(const LAS bf16x8*)(ard + off), a1 = *(const LAS bf16x8*)(ard + off + 512);
        const bf16x8 bb = *(const GAS bf16x8*)(wsrc + 512 * ks);
        acc[0] = mfma32(a0, bb, acc[0]); acc[1] = mfma32(a1, bb, acc[1]);
    }
    __syncthreads();
    LAS bf16* Hs = (LAS bf16*)(F.lds + RING_OFF);
    { float bv = 0.f; const float* bp = (const float*)(A.ws + WS_BPART) + kv * 16 * 256 + 32 * w + r32;
#pragma unroll
      for (int c = 0; c < 16; ++c) bv += bp[c * 256];
#pragma unroll
      for (int rb = 0; rb < 2; ++rb)
#pragma unroll
        for (int r = 0; r < 16; ++r) { const float h = pg8::silu_f(acc[rb][r] + bv); Hs[(32 * rb + crow(r, hi)) * HS_PITCH + 32 * w + r32] = (bf16)f2bf(h); } }
    __syncthreads();
    if (w < 2) {
        f32x16 a2[2]; a2[0] = (f32x16){}; a2[1] = (f32x16){};
#pragma unroll
        for (int ks = 0; ks < 16; ++ks) {
            const bf16x8 a = *(const LAS bf16x8*)(Hs + (32 * w + r32) * HS_PITCH + 16 * ks + 8 * hi);
#pragma unroll
            for (int cb = 0; cb < 2; ++cb) { const bf16x8 bb = *(const GAS bf16x8*)(W2t + (size_t)(32 * cb + r32) * 256 + 16 * ks + 8 * hi); a2[cb] = mfma32(a, bb, a2[cb]); }
        }
        bf16* dst = (kv ? WSB(WS_VCMP) : WSB(WS_KCMP)) + (size_t)bgi * 256 * 64;
        const float* tbl = (const float*)(A.ws + WS_ROPE);
#pragma unroll
        for (int r = 0; r < 16; ++r) {
            const int i = 64 * slab + 32 * w + crow(r, hi); float o1 = a2[0][r], o2 = a2[1][r];
            if (kv == 0) { int tp = 16 * i + 31; tp = tp > SEQ - 1 ? SEQ - 1 : tp; const float cs = tbl[(size_t)(b * SEQ + tp) * 64 + r32], sn = tbl[(size_t)(b * SEQ + tp) * 64 + 32 + r32];
                const float x1 = o1, x2 = o2; o1 = x1 * cs - x2 * sn; o2 = x2 * cs + x1 * sn; }
            if (i >= 255) { o1 = 0.f; o2 = 0.f; }
            dst[(size_t)i * 64 + r32] = (bf16)f2bf(o1); dst[(size_t)i * 64 + 32 + r32] = (bf16)f2bf(o2);
        }
    }
    __syncthreads();
}

template <int ND0>
__device__ __forceinline__ void qkt_c(f32x16& p0, f32x16& p1, const lchar* kslot, const bf16x8* qr, int r32, int hi, const f32x16& cinit) {
    const lchar* kb = kslot + hi * 1024 + r32 * 16;
#pragma unroll
    for (int d0 = 0; d0 < ND0; ++d0) {
        const bf16x8 b0 = *(const LAS bf16x8*)(kb + d0 * 2048), b1 = *(const LAS bf16x8*)(kb + d0 * 2048 + 512);
        if (d0 == 0) { p0 = mfma32(b0, qr[0], cinit); p1 = mfma32(b1, qr[0], cinit); }
        else { p0 = mfma32(b0, qr[d0], p0); p1 = mfma32(b1, qr[d0], p1); }
    }
}
template <int ND0>
__device__ __forceinline__ void qkt(f32x16& p0, f32x16& p1, const lchar* kslot, const bf16x8* qr, int r32, int hi) {
    const lchar* kb = kslot + hi * 1024 + r32 * 16;
    p0 = (f32x16){}; p1 = (f32x16){};
#pragma unroll
    for (int d0 = 0; d0 < ND0; ++d0) {
        const bf16x8 b0 = *(const LAS bf16x8*)(kb + d0 * 2048), b1 = *(const LAS bf16x8*)(kb + d0 * 2048 + 512);
        p0 = mfma32(b0, qr[d0], p0); p1 = mfma32(b1, qr[d0], p1);
    }
}
template <int NDB>
__device__ __forceinline__ void pv(f32x16* o, unsigned vb, bf16x8 pa0, bf16x8 pa1, bf16x8 pa2, bf16x8 pa3) {
#pragma unroll
    for (int d0 = 0; d0 < NDB; ++d0) { s16x4 lo[4], hi[4];
#pragma unroll
        for (int ks = 0; ks < 4; ++ks) {
            asm volatile("ds_read_b64_tr_b16 %0,%1 offset:%c2" : "=&v"(lo[ks]) : "v"(vb), "i"(d0 * 4096 + ks * 1024) : "memory");
            asm volatile("ds_read_b64_tr_b16 %0,%1 offset:%c2" : "=&v"(hi[ks]) : "v"(vb), "i"(d0 * 4096 + ks * 1024 + 512) : "memory"); }
        asm volatile("s_waitcnt lgkmcnt(0)" ::: "memory"); SBAR();
#define PKV(k) (bf16x8){lo[k][0], lo[k][1], lo[k][2], lo[k][3], hi[k][0], hi[k][1], hi[k][2], hi[k][3]}
        o[d0] = mfma32(pa0, PKV(0), o[d0]);
        o[d0] = mfma32(pa1, PKV(1), o[d0]);
        o[d0] = mfma32(pa2, PKV(2), o[d0]);
        o[d0] = mfma32(pa3, PKV(3), o[d0]);
#undef PKV
    }
}
__device__ __forceinline__ float rowmax32(const f32x16& p0, const f32x16& p1) {
    float a = fmaxf(p0[0], p1[0]);
#pragma unroll
    for (int r = 1; r < 16; ++r) a = fmaxf(a, fmaxf(p0[r], p1[r]));
    return pair_max(a);
}
__device__ __forceinline__ void mask_range(f32x16& p0, f32x16& p1, int lo, int hi_, int hi) {
#pragma unroll
    for (int r = 0; r < 16; ++r) { const int kv = crow(r, hi);
        if (kv < lo || kv > hi_) p0[r] = -INFINITY;
        if (kv + 32 < lo || kv + 32 > hi_) p1[r] = -INFINITY; }
}
#define PKW(P, B) cvtpk(P[B], P[B + 1])
#define PACK4(P, B) __builtin_bit_cast(bf16x8, (v4u){PKW(P, B), PKW(P, B + 2), PKW(P, B + 4), PKW(P, B + 6)})

struct TileSrc { const bf16* K; const bf16* V; int pitch; };
__device__ __forceinline__ void tile_load(v4u& kr, v4u& vr, const TileSrc& s, int key0, int lane, int w) {
    kr = *(const GAS v4u*)(s.K + (size_t)(key0 + lane) * s.pitch + w * 8);
    vr = *(const GAS v4u*)(s.V + (size_t)(key0 + 16 * (w & 3) + (lane >> 2)) * s.pitch + (w >> 2) * 32 + (lane & 3) * 8);
}
__device__ __forceinline__ void tile_store(lchar* kslot, lchar* vslot, const v4u& kr, const v4u& vr, int lane, int w) {
    *(LAS v4u*)(kslot + w * 1024 + lane * 16) = kr; *(LAS v4u*)(vslot + w * 1024 + lane * 16) = vr;
}

struct Br { f32x16 o[2]; float m, l; };
__device__ __forceinline__ void flash_tile(Br& st, const lchar* kslot, unsigned vb, const bf16x8* qr, bool need_mask, int mlo, int mhi, LAS float* wsf, int r32, int hi) {
    f32x16 p0, p1; qkt<4>(p0, p1, kslot, qr, r32, hi);
    if (need_mask) mask_range(p0, p1, mlo, mhi, hi);
    const float rm = rowmax32(p0, p1);
    if (__any(rm > st.m)) {
        const float mn = fmaxf(st.m, rm); const float al = (mn == -INFINITY) ? 1.0f : __builtin_amdgcn_exp2f(st.m - mn);
        st.l *= al; st.m = mn;
        if (hi == 0) wsf[r32] = al;
        LDS_WAIT(); asm volatile("" ::: "memory");
#pragma unroll
        for (int r = 0; r < 16; ++r) { const float a = wsf[crow(r, hi)]; st.o[0][r] *= a; st.o[1][r] *= a; }
    }
    const float ms = (st.m == -INFINITY) ? 0.f : st.m;
    float s = 0.f;
#pragma unroll
    for (int r = 0; r < 16; ++r) { p0[r] = __builtin_amdgcn_exp2f(p0[r] - ms); p1[r] = __builtin_amdgcn_exp2f(p1[r] - ms); s += p0[r] + p1[r]; }
    st.l += s;
    pv<2>(st.o, vb, PACK4(p0, 0), PACK4(p0, 8), PACK4(p1, 0), PACK4(p1, 8));
}

constexpr int NS_GATE = 117504;
constexpr int NS_YSTG = 51200, NS_IMP = NS_YSTG, NS_CV = NS_IMP + 16896, IMP_P = 65, NS_SELM = NS_YSTG + 65536, NS_RSQ = NS_SELM + 512;
static_assert(ab::LDS_END <= NS_YSTG && NS_RSQ + 256 <= NS_GATE && NS_GATE + 6144 <= RING_BYTES, "NSA LDS map");
__device__ __forceinline__ void mask_gt(f32x16& c0, f32x16& c1, int tl, int hi) {
    int thr = tl - 4 * hi; asm volatile("" : "+v"(thr));
#pragma unroll
    for (int r = 0; r < 16; ++r) { const int c = crow(r, 0); c0[r] = (c > thr) ? -INFINITY : c0[r]; c1[r] = (c + 32 > thr) ? -INFINITY : c1[r]; }
}
__device__ __forceinline__ void mask_le(f32x16& c0, f32x16& c1, int tl, int hi) {
    int thr = tl - 4 * hi; asm volatile("" : "+v"(thr));
#pragma unroll
    for (int r = 0; r < 16; ++r) { const int c = crow(r, 0); c0[r] = (c <= thr) ? -INFINITY : c0[r]; c1[r] = (c + 32 <= thr) ? -INFINITY : c1[r]; }
}
#ifndef STREAM_THR
#define STREAM_THR 16
#endif
struct MaskSlc { unsigned long long sel; int nT, qt, tl;
    __device__ __forceinline__ void operator()(f32x16& c0, f32x16& c1, int j, int hi) const {
        const bool off = (j >= nT) || (((sel >> j) & 1ull) == 0ull);
        if (__any(off)) {
#pragma unroll
            for (int r = 0; r < 16; ++r) { c0[r] = off ? -INFINITY : c0[r]; c1[r] = off ? -INFINITY : c1[r]; }
        }
#if defined(PROBE_DUP) && PROBE_DUP == 13
        asm volatile("" : "+v"(c0), "+v"(c1));
        if (__any(off)) {
#pragma unroll
            for (int r = 0; r < 16; ++r) { c0[r] = off ? -INFINITY : c0[r]; c1[r] = off ? -INFINITY : c1[r]; }
        }
#endif
        if (j == qt) mask_gt(c0, c1, tl, hi);
    }
};
struct MaskWin { int nT, qt, tl, t_lo;
    __device__ __forceinline__ void operator()(f32x16& c0, f32x16& c1, int j, int hi) const {
        const int T = t_lo + j; const bool pad = j >= nT;
        if (pad || T == qt || T == qt - 8) {
            int up = (pad ? -1 : (T == qt ? tl : 1000)) - 4 * hi, lo = (T == qt - 8 ? tl : -1000) - 4 * hi; asm volatile("" : "+v"(up), "+v"(lo));
#pragma unroll
            for (int r = 0; r < 16; ++r) { const int c = crow(r, 0); c0[r] = (c > up || c <= lo) ? -INFINITY : c0[r]; c1[r] = (c + 32 > up || c + 32 <= lo) ? -INFINITY : c1[r]; }
        }
    }
};
__device__ __forceinline__ void nsa_unit(Frame& F, const Args& A, int b, int qt) {
    const int w = F.wave, tid = F.tid;
#define FRESH_LANE() int lane = F.lane; asm volatile("" : "+v"(lane)); const int r32 = lane & 31, hi = lane >> 5; (void)r32; (void)hi
#define LANE_VARS() const int qi = r32 & 7, hd = r32 >> 3, tl = 8 * w + qi; const size_t mytok = tok0 + 64 * qt + tl; (void)hd; (void)mytok
    lchar* ring = (lchar*)(F.lds + RING_OFF);
    char* shm = (char*)(F.lds + RING_OFF);
    LAS float* wsf = (LAS float*)(ring + ab::LDS_WS) + w * 64;
    LAS float* IMP = (LAS float*)(ring + NS_IMP);
    LAS unsigned long long* SELM = (LAS unsigned long long*)(ring + NS_SELM);
    LAS float* RSQ = (LAS float*)(ring + NS_RSQ);
    LAS float* ystg = (LAS float*)(ring + NS_YSTG) + w * 2048;
#define VLANE() ((unsigned)(((lane >> 4) & 1) * 32 + (lane & 3) * 8 + (4 * hi + ((lane & 15) >> 2)) * 64))
    const unsigned ring_addr = (unsigned)(uintptr_t)ring;
    const size_t tok0 = (size_t)b * SEQ;
    if (tid < 64) RSQ[tid] = 0.f;

#pragma nounroll
    for (int g = 0; g < 2; ++g) {
        const int ntc = ((4 * qt + 2) >> 6) + 1;
        v4u kr4[4], vr4[4];
        { FRESH_LANE(); const bf16* Kc = WSB(WS_KCMP) + (size_t)(b * 2 + g) * 256 * 64; const bf16* Vc = WSB(WS_VCMP) + (size_t)(b * 2 + g) * 256 * 64;
#pragma unroll
          for (int T = 0; T < 4; ++T) { const int Tc = T < ntc ? T : 0;
              kr4[T] = *(const GAS v4u*)(Kc + (size_t)(64 * Tc + 8 * w + (lane >> 3)) * 64 + (lane & 7) * 8);
              vr4[T] = *(const GAS v4u*)(Vc + (size_t)(64 * Tc + 16 * (w & 3) + (lane >> 2)) * 64 + (w >> 2) * 32 + (lane & 3) * 8); } }
        bf16x8 qr[4];
#if defined(PROBE_DUP) && PROBE_DUP == 8
        for (int rep_ = 0; rep_ < 2; ++rep_)
#endif
#define GATE(k) (((LAS float*)(ring + NS_GATE))[(k) * 512 + tid])
        { FRESH_LANE(); LANE_VARS();
        { const bf16* qp = WSB(WS_PROJ) + mytok * NPROJ + COL_Q + (g * 4 + hd) * 64 + 8 * hi;
          v4u raw[4];
#pragma unroll
          for (int d0 = 0; d0 < 4; ++d0) raw[d0] = __builtin_nontemporal_load((const GAS v4u*)(qp + 16 * d0));
          const float* tb = (const float*)(A.ws + WS_ROPE) + mytok * 64 + 8 * hi;
#pragma unroll
          for (int dl = 0; dl < 2; ++dl) {
              const f32x4 c0 = *(const GAS f32x4*)(tb + 16 * dl), c1 = *(const GAS f32x4*)(tb + 16 * dl + 4), s0 = *(const GAS f32x4*)(tb + 32 + 16 * dl), s1 = *(const GAS f32x4*)(tb + 32 + 16 * dl + 4);
              const float cs[8] = {c0.x, c0.y, c0.z, c0.w, c1.x, c1.y, c1.z, c1.w}, sn[8] = {s0.x, s0.y, s0.z, s0.w, s1.x, s1.y, s1.z, s1.w};
              const v4u a = raw[dl], bq = raw[dl + 2];
              const float x1[8] = {bflo(a.x), bfhi(a.x), bflo(a.y), bfhi(a.y), bflo(a.z), bfhi(a.z), bflo(a.w), bfhi(a.w)};
              const float x2[8] = {bflo(bq.x), bfhi(bq.x), bflo(bq.y), bfhi(bq.y), bflo(bq.z), bfhi(bq.z), bflo(bq.w), bfhi(bq.w)};
              float o1[8], o2[8];
#pragma unroll
              for (int j = 0; j < 8; ++j) { o1[j] = (x1[j] * cs[j] - x2[j] * sn[j]) * C2_NSA; o2[j] = (x2[j] * cs[j] + x1[j] * sn[j]) * C2_NSA; }
              qr[dl] = __builtin_bit_cast(bf16x8, (v4u){cvtpk(o1[0], o1[1]), cvtpk(o1[2], o1[3]), cvtpk(o1[4], o1[5]), cvtpk(o1[6], o1[7])});
              qr[dl + 2] = __builtin_bit_cast(bf16x8, (v4u){cvtpk(o2[0], o2[1]), cvtpk(o2[2], o2[3]), cvtpk(o2[4], o2[5]), cvtpk(o2[6], o2[7])});
          } }
        { const bf16* gp = WSB(WS_PROJ) + mytok * NPROJ + COL_GL + (g * 4 + hd) * 3;
#pragma unroll
          for (int k = 0; k < 3; ++k) GATE(k) = __builtin_amdgcn_rcpf(1.0f + __builtin_amdgcn_exp2f(-LOG2E * bf2f(gp[k]))); }
        }
        f32x16 y[2];
#if defined(PROBE_DUP) && PROBE_DUP == 7
        for (int rep_ = 0; rep_ < 2; ++rep_) {
        if (rep_) __syncthreads();
#else
        {
#endif
        y[0] = (f32x16){}; y[1] = (f32x16){};

#ifndef X_NOCMP
        { FRESH_LANE(); LANE_VARS(); const unsigned vlane = VLANE();
            const int imax = (64 * qt + tl - 31) >> 4;
            const int imax_w = (64 * qt + 8 * w - 31) >> 4;
            {
#pragma unroll
              for (int T = 0; T < 4; ++T) if (T < ntc) { *(LAS v4u*)(ring + T * 8192 + (lane & 7) * 1024 + (8 * w + (lane >> 3)) * 16) = kr4[T]; *(LAS v4u*)(ring + NS_CV + T * 8192 + w * 1024 + lane * 16) = vr4[T]; } }
            __syncthreads();
            float m = -INFINITY, l = 0.f;
#pragma nounroll
            for (int T = 0; T < ntc; ++T) {
                f32x16 p0, p1; qkt<4>(p0, p1, ring + T * 8192, qr, r32, hi); if (64 * T + 63 > imax_w) mask_gt(p0, p1, imax - 64 * T, hi);
                const float rm = rowmax32(p0, p1), mn = fmaxf(m, rm);
                const float al = (mn == -INFINITY) ? 1.0f : __builtin_amdgcn_exp2f(m - mn); l *= al; m = mn;
                const float msa = (mn == -INFINITY) ? 0.f : mn; float sm = 0.f;
#pragma unroll
                for (int r = 0; r < 16; ++r) sm += __builtin_amdgcn_exp2f(p0[r] - msa) + __builtin_amdgcn_exp2f(p1[r] - msa);
                l += sm;
            }
            l = pair_sum(l);
            f32x16 cinit; { const float c_ = (l > 0.f) ? -(m + __builtin_amdgcn_logf(l)) : -INFINITY;
#pragma unroll
                for (int r = 0; r < 16; ++r) cinit[r] = c_; }
            float carry = 0.f;
#pragma nounroll
            for (int T = 0; T < ntc; ++T) {
                f32x16 p0, p1; qkt_c<4>(p0, p1, ring + T * 8192, qr, r32, hi, cinit); if (64 * T + 63 > imax_w) mask_gt(p0, p1, imax - 64 * T, hi);
#pragma unroll
                for (int r = 0; r < 16; ++r) { p0[r] = __builtin_amdgcn_exp2f(p0[r]); p1[r] = __builtin_amdgcn_exp2f(p1[r]); }
                { float ia[8], ic[8];
#pragma unroll
                  for (int rq = 0; rq < 4; ++rq) { ic[rq] = 0.5f * p0[4 * rq + 3]; ia[rq] = (p0[4 * rq] + p0[4 * rq + 1]) + (p0[4 * rq + 2] + ic[rq]);
                      ic[4 + rq] = 0.5f * p1[4 * rq + 3]; ia[4 + rq] = (p1[4 * rq] + p1[4 * rq + 1]) + (p1[4 * rq + 2] + ic[4 + rq]); }
#pragma unroll
                  for (int i = 0; i < 8; ++i) { ia[i] += __shfl_xor(ia[i], 8); ia[i] += __shfl_xor(ia[i], 16); ic[i] += __shfl_xor(ic[i], 8); ic[i] += __shfl_xor(ic[i], 16); }
                  float cp[8];
#pragma unroll
                  for (int i = 0; i < 8; ++i) cp[i] = __shfl_xor(ic[i], 32);
                  LAS float* imq = IMP + tl * IMP_P + 16 * T + hi;
#pragma unroll
                  for (int i = 0; i < 8; ++i) { const float prev = hi ? cp[i] : (i > 0 ? cp[i - 1] : carry); const float v = ia[i] + prev; if (hd == 0) imq[8 * (i >> 2) + 2 * (i & 3)] = v; }
                  carry = cp[7]; }
                pv<2>(y, ring_addr + NS_CV + T * 8192 + vlane, PACK4(p0, 0), PACK4(p0, 8), PACK4(p1, 0), PACK4(p1, 8));
            }

        }
#endif
        }
        __syncthreads();
#ifndef X_NOTOPK
        { FRESH_LANE();
            const bool forced = (lane == 0) || (lane == qt) || (lane == qt - 1); const bool future = lane > qt;
#if defined(PROBE_DUP) && PROBE_DUP == 3
            for (int rep_ = 0; rep_ < 2; ++rep_)
#endif
            {
                LAS unsigned* KT = (LAS unsigned*)(ring + NS_CV) + w * 512;
                unsigned key[8];
#pragma unroll
                for (int k8 = 0; k8 < 8; ++k8) { const unsigned vb_ = __float_as_uint(IMP[(8 * w + k8) * IMP_P + lane]);
                    key[k8] = (forced ? 0x7f000000u : (future ? 0u : ((vb_ & ~63u) + 64u))) | (unsigned)(63 - lane); KT[k8 * 64 + lane] = key[k8]; }
                LDS_WAIT(); asm volatile("" ::: "memory");
                const int nk = (qt >> 2) + 1;
#pragma unroll
                for (int k8 = 0; k8 < 8; k8 += 2) { int r0 = 0, r1 = 0; const LAS v4u* ka = (const LAS v4u*)(KT + k8 * 64); const LAS v4u* kb = (const LAS v4u*)(KT + (k8 + 1) * 64);
#pragma nounroll
                    for (int k4 = 0; k4 < nk; ++k4) { const v4u a = ka[k4], c = kb[k4];
                        r0 += (int)(a.x > key[k8]) + (int)(a.y > key[k8]) + (int)(a.z > key[k8]) + (int)(a.w > key[k8]);
                        r1 += (int)(c.x > key[k8 + 1]) + (int)(c.y > key[k8 + 1]) + (int)(c.z > key[k8 + 1]) + (int)(c.w > key[k8 + 1]); }
                    const unsigned long long m0 = __ballot(r0 < 16), m1 = __ballot(r1 < 16);
                    if (lane == 0) { SELM[8 * w + k8] = m0; SELM[8 * w + k8 + 1] = m1; } }
            }
        }
#endif
        __syncthreads();
        unsigned long long mysel;
        { FRESH_LANE(); LANE_VARS(); mysel = SELM[tl];
        { LAS float* ysb = ystg + 256 * hi + r32; asm volatile("" : "+v"(ysb));
          LAS float* grow = (LAS float*)(ring + NS_GATE) + 64 * w + 4 * hi; asm volatile("" : "+v"(grow));
#pragma unroll
          for (int r = 0; r < 16; ++r) { const float a = grow[crow(r, 0)]; ysb[crow(r, 0) * 64] = a * y[0][r]; ysb[crow(r, 0) * 64 + 32] = a * y[1][r]; } } }

        {
            f32x16 o[2]; float l;
#if !defined(X_NOSLC)
            { FRESH_LANE(); LANE_VARS(); const MaskSlc mk{mysel, qt + 1, qt, tl};
              ab::attn_stream<STREAM_THR, MaskSlc>((const ab::bf16*)(WSB(WS_PROJ) + tok0 * NPROJ + COL_KSL + g * 64), (const ab::bf16*)(WSB(WS_PROJ) + tok0 * NPROJ + COL_VSL + g * 64), 0, qt + 1, qr, mk, shm, o, l, lane); }
            { FRESH_LANE(); LANE_VARS(); const float fsc = l > 0.f ? GATE(1) * __builtin_amdgcn_rcpf(l) : 0.f;
              if (hi == 0) wsf[r32] = fsc;
              LDS_WAIT(); asm volatile("" ::: "memory");
              LAS float* ysb = ystg + 256 * hi + r32; asm volatile("" : "+v"(ysb)); LAS float* wsh = wsf + 4 * hi; asm volatile("" : "+v"(wsh));
#pragma unroll
              for (int r = 0; r < 16; ++r) { const float a = wsh[crow(r, 0)]; ysb[crow(r, 0) * 64] += a * o[0][r]; ysb[crow(r, 0) * 64 + 32] += a * o[1][r]; } }
#endif
#if !defined(X_NOWIN)
            { FRESH_LANE(); LANE_VARS(); const int t_lo = qt >= 8 ? qt - 8 : 0; const MaskWin mk{qt - t_lo + 1, qt, tl, t_lo};
              ab::attn_stream<STREAM_THR, MaskWin>((const ab::bf16*)(WSB(WS_PROJ) + tok0 * NPROJ + COL_KW + g * 64), (const ab::bf16*)(WSB(WS_PROJ) + tok0 * NPROJ + COL_VW + g * 64), t_lo, qt - t_lo + 1, qr, mk, shm, o, l, lane); }
            { FRESH_LANE(); LANE_VARS(); const float fsc = l > 0.f ? GATE(2) * __builtin_amdgcn_rcpf(l) : 0.f;
              if (hi == 0) wsf[r32] = fsc;
              LDS_WAIT(); asm volatile("" ::: "memory");
              LAS float* ysb = ystg + 256 * hi + r32; asm volatile("" : "+v"(ysb)); LAS float* wsh = wsf + 4 * hi; asm volatile("" : "+v"(wsh));
#pragma unroll
              for (int r = 0; r < 16; ++r) { const float a = wsh[crow(r, 0)]; ysb[crow(r, 0) * 64] += a * o[0][r]; ysb[crow(r, 0) * 64 + 32] += a * o[1][r]; } }
#endif
        }
        LDS_WAIT(); asm volatile("" ::: "memory");
        { FRESH_LANE(); float pa = 0.f, pb = 0.f;
#pragma unroll
          for (int i = 0; i < 8; ++i) { const int c = lane + 64 * i, row = c >> 4, c16 = c & 15;
              const f32x4 v = *(const LAS f32x4*)(ystg + row * 64 + 4 * c16);
              const float sq = (v.x * v.x + v.y * v.y) + (v.z * v.z + v.w * v.w); if (i & 1) pb += sq; else pa += sq;
              const unsigned long long pk = (unsigned long long)cvtpk(v.x, v.y) | ((unsigned long long)cvtpk(v.z, v.w) << 32);
              *(GAS unsigned long long*)(WSB(WS_MIXED) + (tok0 + 64 * qt + 8 * w + (row & 7)) * DM + 512 + (g * 4 + (row >> 3)) * 64 + 4 * c16) = pk; }
          pa = row16_sum(pa); pb = row16_sum(pb);
          if ((lane & 15) == 0) { RSQ[8 * w + (lane >> 4)] += pa; RSQ[8 * w + 4 + (lane >> 4)] += pb; } }
        __syncthreads();
    }
    asm volatile("s_waitcnt vmcnt(0)" ::: "memory");
#ifndef X_NOFINAL
    { FRESH_LANE();
      const int s0 = 64 * qt + 8 * w; const bf16* rowp = WSB(WS_PROJ) + (tok0 + s0) * NPROJ + 8 * lane;
      v4u zv[10], bgv[8];
#pragma unroll
      for (int i = 0; i < 10; ++i) { const bool ok = (s0 - 2 + i) >= 0; const bf16* rp = rowp + (ptrdiff_t)(ok ? i - 2 : 0) * NPROJ; zv[i] = __builtin_nontemporal_load((const GAS v4u*)(rp + COL_CG)); if (!ok) { zv[i] = (v4u){0u, 0u, 0u, 0u}; } }
#pragma unroll
      for (int i = 0; i < 8; ++i) bgv[i] = __builtin_nontemporal_load((const GAS v4u*)(rowp + (size_t)i * NPROJ + COL_BG));
      { bf16* yp = WSB(WS_MIXED) + (tok0 + 64 * qt + 8 * w) * DM + 512 + 8 * lane;
        v4u yv[8];
#pragma unroll
        for (int k8 = 0; k8 < 8; ++k8) yv[k8] = *(const GAS v4u*)(yp + (size_t)k8 * DM);
        const f32x4 g0 = *(const GAS f32x4*)(INF(13) + 8 * lane), g1 = *(const GAS f32x4*)(INF(13) + 8 * lane + 4);
#pragma unroll
        for (int k8 = 0; k8 < 8; ++k8) {
            const float rstd = __builtin_amdgcn_rsqf(RSQ[8 * w + k8] * (1.f / 512.f) + EPS); const v4u y4 = yv[k8];
            v4u o; o.x = pk2(bflo(y4.x) * rstd * g0.x, bfhi(y4.x) * rstd * g0.y); o.y = pk2(bflo(y4.y) * rstd * g0.z, bfhi(y4.y) * rstd * g0.w);
            o.z = pk2(bflo(y4.z) * rstd * g1.x, bfhi(y4.z) * rstd * g1.y); o.w = pk2(bflo(y4.w) * rstd * g1.z, bfhi(y4.w) * rstd * g1.w);
            *(GAS v4u*)(yp + (size_t)k8 * DM) = o; } }
#if defined(PROBE_DUP) && PROBE_DUP == 26
      for (int rep_ = 0; rep_ < 2; ++rep_)
#endif
      { float cw[3][8];
#pragma unroll
        for (int k = 0; k < 3; ++k) { const f32x4 a0 = *(const GAS f32x4*)(INF(5) + k * 512 + 8 * lane), a1 = *(const GAS f32x4*)(INF(5) + k * 512 + 8 * lane + 4);
            cw[k][0] = a0.x; cw[k][1] = a0.y; cw[k][2] = a0.z; cw[k][3] = a0.w; cw[k][4] = a1.x; cw[k][5] = a1.y; cw[k][6] = a1.z; cw[k][7] = a1.w; }
        const f32x4 gc0 = *(const GAS f32x4*)(INF(12) + 8 * lane), gc1 = *(const GAS f32x4*)(INF(12) + 8 * lane + 4);
        const float gc[8] = {gc0.x, gc0.y, gc0.z, gc0.w, gc1.x, gc1.y, gc1.z, gc1.w};
        {
#pragma unroll
            for (int i = 0; i < 8; ++i) {
                const float bgf[8] = {bflo(bgv[i].x), bfhi(bgv[i].x), bflo(bgv[i].y), bfhi(bgv[i].y), bflo(bgv[i].z), bfhi(bgv[i].z), bflo(bgv[i].w), bfhi(bgv[i].w)};
                const v4u za = zv[i], zb = zv[i + 1], zc = zv[i + 2];
                const float z0[8] = {bflo(za.x), bfhi(za.x), bflo(za.y), bfhi(za.y), bflo(za.z), bfhi(za.z), bflo(za.w), bfhi(za.w)};
                const float z1[8] = {bflo(zb.x), bfhi(zb.x), bflo(zb.y), bfhi(zb.y), bflo(zb.z), bfhi(zb.z), bflo(zb.w), bfhi(zb.w)};
                const float z2[8] = {bflo(zc.x), bfhi(zc.x), bflo(zc.y), bfhi(zc.y), bflo(zc.z), bfhi(zc.z), bflo(zc.w), bfhi(zc.w)};
                float v[8], s2 = 0.f;
#pragma unroll
                for (int e = 0; e < 8; ++e) { v[e] = bgf[e] * (cw[0][e] * z0[e] + cw[1][e] * z1[e] + cw[2][e] * z2[e]); s2 += v[e] * v[e]; }
                const float rstd = __builtin_amdgcn_rsqf(wave_sum(s2) * (1.f / 512.f) + EPS);
                v4u o; o.x = pk2(v[0] * rstd * gc[0], v[1] * rstd * gc[1]); o.y = pk2(v[2] * rstd * gc[2], v[3] * rstd * gc[3]); o.z = pk2(v[4] * rstd * gc[4], v[5] * rstd * gc[5]); o.w = pk2(v[6] * rstd * gc[6], v[7] * rstd * gc[7]);
                *(GAS v4u*)(WSB(WS_MIXED) + (tok0 + s0 + i) * DM + 8 * lane) = o; }
        } }
    }
#endif
    __syncthreads();
#undef FRESH_LANE
#undef GATE
#undef LANE_VARS
#undef VLANE
}

struct RowRaw { unsigned long long z[4], b[4]; float ir; };
template <bool FINAL>
__device__ __forceinline__ void resnorm_load(RowRaw& q, const bf16* Zb, const bf16* hb, const float* rstd_io, int m, int lane) {
    const GAS unsigned long long* zr = (const GAS unsigned long long*)(Zb + (size_t)m * DM) + lane; const GAS unsigned long long* br = (const GAS unsigned long long*)(hb + (size_t)m * DM) + lane;
#pragma unroll
    for (int j = 0; j < 4; ++j) { q.z[j] = __builtin_nontemporal_load(zr + 64 * j); q.b[j] = FINAL ? __builtin_nontemporal_load(br + 64 * j) : br[64 * j]; }
    q.ir = rstd_io[m];
}
template <bool FINAL>
__device__ __forceinline__ void resnorm_rows(Frame& F, const bf16* Zb, const float* g1, bf16* hb, float* rstd_io, float* outf) {
    const int NGW = F.G * NWAVES, lane = F.lane;
    const bool xal = (F.G == 256); const int gwx = xal ? (F.vx * SEQ + F.vr * NWAVES + F.wave) : (F.vcu * NWAVES + F.wave); const int rstep = xal ? 256 : NGW; const int nrow = xal ? F.vx * SEQ + SEQ : MTOK;
    f32x4 gg[4];
#pragma unroll
    for (int j = 0; j < 4; ++j) gg[j] = ((const GAS f32x4*)g1 + lane)[64 * j];
    RowRaw cur[2], nxt[2];
    if (gwx < nrow) {
#pragma unroll
        for (int r = 0; r < 2; ++r) resnorm_load<FINAL>(cur[r], Zb, hb, rstd_io, (gwx + r * rstep) < nrow ? (gwx + r * rstep) : gwx, lane); }
    for (int m0 = gwx; m0 < nrow; m0 += 2 * rstep) {
        const int mn = m0 + 2 * rstep;
        if (mn < nrow) {
#pragma unroll
            for (int r = 0; r < 2; ++r) resnorm_load<FINAL>(nxt[r], Zb, hb, rstd_io, (mn + r * rstep) < nrow ? (mn + r * rstep) : mn, lane); }
#pragma unroll
        for (int r = 0; r < 2; ++r) { const int m = m0 + r * rstep; float s2 = 0.f; f32x4 z[4], h[4]; const float ir = 1.0f / cur[r].ir;
#pragma unroll
            for (int j = 0; j < 4; ++j) { const unsigned lo = (unsigned)cur[r].z[j], hi = (unsigned)(cur[r].z[j] >> 32); z[j] = (f32x4){bflo(lo), bfhi(lo), bflo(hi), bfhi(hi)};
                const unsigned l2 = (unsigned)cur[r].b[j], h2_ = (unsigned)(cur[r].b[j] >> 32); h[j] = (f32x4){bflo(l2), bfhi(l2), bflo(h2_), bfhi(h2_)} * ir;
                s2 += (z[j].x * z[j].x + z[j].y * z[j].y) + (z[j].z * z[j].z + z[j].w * z[j].w); }
            const float rstd = 1.0f / sqrtf(wave_sum(s2) * (1.f / DM) + EPS);
            float h2 = 0.f;
#pragma unroll
            for (int j = 0; j < 4; ++j) { h[j] = h[j] + z[j] * rstd * gg[j]; h2 += (h[j].x * h[j].x + h[j].y * h[j].y) + (h[j].z * h[j].z + h[j].w * h[j].w); }
            if (FINAL) { if (m < nrow) {
#pragma unroll
                for (int j = 0; j < 4; ++j) __builtin_nontemporal_store(h[j], (GAS f32x4*)(outf + (size_t)m * DM) + lane + 64 * j); } }
            else {
                const float rs2 = 1.0f / sqrtf(wave_sum(h2) * (1.f / DM) + EPS);
                if (m < nrow) { GAS unsigned long long* o8 = (GAS unsigned long long*)(hb + (size_t)m * DM) + lane;
#pragma unroll
                    for (int j = 0; j < 4; ++j) { const f32x4 y = h[j] * rs2; o8[64 * j] = (unsigned long long)pk2(y.x, y.y) | ((unsigned long long)pk2(y.z, y.w) << 32); }
                    if (lane == 0) rstd_io[m] = rs2; } }
        }
        cur[0] = nxt[0]; cur[1] = nxt[1];
    }
}

#ifndef GEMM_ALIGN
#define GEMM_ALIGN true
#endif
#ifndef GEMM_SP2
#define GEMM_SP2 true
#endif
#ifndef GEMM_A_AUX
#define GEMM_A_AUX 0
#endif
#ifndef GEMM_A_AUX_DOWN
#define GEMM_A_AUX_DOWN 0
#endif
__device__ __forceinline__ void warm_buffer(const void* p, size_t bytes) {
    const v4u* q = (const v4u*)p; const size_t n = bytes / 16, stride = (size_t)gridDim.x * 512;
    v4u acc = (v4u){0u, 0u, 0u, 0u};
    for (size_t i = (size_t)blockIdx.x * 512 + threadIdx.x; i < n; i += stride) { const v4u v = *(const GAS v4u*)(q + i); acc.x |= v.x; acc.y |= v.y; acc.z |= v.z; acc.w |= v.w; }
    asm volatile("" :: "v"(acc.x), "v"(acc.y), "v"(acc.z), "v"(acc.w));
}
constexpr int N_PHASES = 13;
template <bool BASE_NORM, bool FINAL>
struct EpiResid {
    static constexpr bool PERM = true, AFTER_DRAIN = false, CAN_SPLIT = false;
    bf16* hb; const float* rstd_b; const float* g1; float* sqz; float* sqh; float* outf; unsigned* cnt; unsigned* tmo; LAS float* P; bool xl;
    __device__ __forceinline__ void operator()(const pg8::f32x4 (&acc_)[2][2][4][2], const pg8::Unit& u, int wr, int wc, int fr, int fq) const {
        pg8::f32x4 (&acc)[2][2][4][2] = const_cast<pg8::f32x4 (&)[2][2][4][2]>(acc_);
        const int tid = threadIdx.x; const int rl0 = wr * 64 + fr; const int row0 = u.pm * 256 + rl0, col0 = u.pn * 256 + wc * 64 + 8 * fq;
        v4u pre[4][2];
#pragma unroll
        for (int ai = 0; ai < 2; ++ai)
#pragma unroll
            for (int m = 0; m < 4; ++m) { float ps = 0.f;
#pragma unroll
                for (int bj = 0; bj < 2; ++bj)
#pragma unroll
                    for (int n = 0; n < 2; ++n) { const pg8::f32x4 x = acc[ai][bj][m][n]; ps += (x[0] * x[0] + x[1] * x[1]) + (x[2] * x[2] + x[3] * x[3]); }
                ps = rows4_sum(ps);
                if (fq == 0) P[(ai * 128 + m * 16 + rl0) * 4 + wc] = ps; }
        asm volatile("s_waitcnt lgkmcnt(0)" ::: "memory"); __builtin_amdgcn_s_barrier(); asm volatile("" ::: "memory");
        if (tid < 256) { const f32x4 p4 = *(const LAS f32x4*)(P + 4 * tid); sqz[(size_t)(u.pm * 256 + tid) * 4 + u.pn] = (p4.x + p4.y) + (p4.z + p4.w); }
        asm volatile("s_waitcnt vmcnt(0) lgkmcnt(0)" ::: "memory"); __builtin_amdgcn_s_barrier(); asm volatile("" ::: "memory");
        f32x4 gg[2][2];
#pragma unroll
        for (int bj = 0; bj < 2; ++bj)
#pragma unroll
            for (int n = 0; n < 2; ++n) gg[bj][n] = *(const GAS f32x4*)(g1 + col0 + 32 * bj + 4 * n);
#pragma unroll
        for (int m = 0; m < 4; ++m)
#pragma unroll
            for (int bj = 0; bj < 2; ++bj) pre[m][bj] = *(const GAS v4u*)(hb + (size_t)(row0 + m * 16) * DM + col0 + 32 * bj);
        if (tid == 0) {
            if (!xl) __builtin_amdgcn_fence(__ATOMIC_RELEASE, "agent");
            __hip_atomic_fetch_add(cnt + u.pm * PCNT_STRIDE, 1u, __ATOMIC_RELAXED, __HIP_MEMORY_SCOPE_AGENT);
            XB_SPIN(xb_ld(cnt + u.pm * PCNT_STRIDE) < 4u, tmo - XB_TMO);
            if (!xl) { __builtin_amdgcn_fence(__ATOMIC_ACQUIRE, "agent"); asm volatile("s_waitcnt vmcnt(0)" ::: "memory"); }
        }
        __builtin_amdgcn_s_barrier(); asm volatile("" ::: "memory");
        LAS float* R = P + 1024;
        if (tid < 256) { const int row = u.pm * 256 + tid; const f32x4 s4 = *(const GAS f32x4*)(sqz + (size_t)row * 4);
            R[tid] = __builtin_amdgcn_rsqf(((s4.x + s4.y) + (s4.z + s4.w)) * (1.f / DM) + EPS); if (BASE_NORM) R[256 + tid] = __builtin_amdgcn_rcpf(rstd_b[row]); }
        asm volatile("s_waitcnt lgkmcnt(0)" ::: "memory"); __builtin_amdgcn_s_barrier(); asm volatile("" ::: "memory");
#pragma unroll
        for (int ai = 0; ai < 2; ++ai) {
#pragma unroll
            for (int m = 0; m < 4; ++m) { const int row = row0 + ai * 128 + m * 16;
                const float rzv = R[ai * 128 + m * 16 + rl0], irv = BASE_NORM ? R[256 + ai * 128 + m * 16 + rl0] : 1.f;
                float hs = 0.f; v4u obj[2]; const bool lo_ = fr < 8;
#pragma unroll
                for (int bj = 0; bj < 2; ++bj) { const v4u q = pre[m][bj];
                    f32x4 b0 = (f32x4){bflo(q.x), bfhi(q.x), bflo(q.y), bfhi(q.y)}, b1 = (f32x4){bflo(q.z), bfhi(q.z), bflo(q.w), bfhi(q.w)};
                    if (BASE_NORM) { b0 *= irv; b1 *= irv; }
                    const f32x4 h0 = b0 + acc[ai][bj][m][0] * rzv * gg[bj][0], h1 = b1 + acc[ai][bj][m][1] * rzv * gg[bj][1];
                    const bool lo = fr < 8; const int rowA = row - fr + (fr & 7), rowB = rowA + 8;
                    if (FINAL) { f32x4 give, recv;
#pragma unroll
                        for (int e = 0; e < 4; ++e) { give[e] = lo ? h1[e] : h0[e]; recv[e] = dpp_ror<0x128>(give[e]); }
                        f32x4 dA, dB;
#pragma unroll
                        for (int e = 0; e < 4; ++e) { dA[e] = lo ? h0[e] : recv[e]; dB[e] = lo ? recv[e] : h1[e]; }
                        const int cc = col0 + 32 * bj + (lo ? 0 : 4);
                        __builtin_nontemporal_store(dA, (GAS f32x4*)(outf + (size_t)rowA * DM + cc)); __builtin_nontemporal_store(dB, (GAS f32x4*)(outf + (size_t)rowB * DM + cc)); }
                    else { hs += ((h0[0] * h0[0] + h0[1] * h0[1]) + (h0[2] * h0[2] + h0[3] * h0[3])) + ((h1[0] * h1[0] + h1[1] * h1[1]) + (h1[2] * h1[2] + h1[3] * h1[3]));
                        v4u o; o.x = pk2(h0[0], h0[1]); o.y = pk2(h0[2], h0[3]); o.z = pk2(h1[0], h1[1]); o.w = pk2(h1[2], h1[3]);
                        obj[bj] = o; } }
                if (!FINAL) { v4u give, recv;
                    give.x = lo_ ? obj[1].x : obj[0].x; give.y = lo_ ? obj[1].y : obj[0].y; give.z = lo_ ? obj[1].z : obj[0].z; give.w = lo_ ? obj[1].w : obj[0].w;
                    recv.x = (unsigned)__builtin_amdgcn_update_dpp(0, (int)give.x, 0x128, 0xf, 0xf, false); recv.y = (unsigned)__builtin_amdgcn_update_dpp(0, (int)give.y, 0x128, 0xf, 0xf, false);
                    recv.z = (unsigned)__builtin_amdgcn_update_dpp(0, (int)give.z, 0x128, 0xf, 0xf, false); recv.w = (unsigned)__builtin_amdgcn_update_dpp(0, (int)give.w, 0x128, 0xf, 0xf, false);
                    v4u dA, dB; dA.x = lo_ ? obj[0].x : recv.x; dA.y = lo_ ? obj[0].y : recv.y; dA.z = lo_ ? obj[0].z : recv.z; dA.w = lo_ ? obj[0].w : recv.w;
                    dB.x = lo_ ? recv.x : obj[1].x; dB.y = lo_ ? recv.y : obj[1].y; dB.z = lo_ ? recv.z : obj[1].z; dB.w = lo_ ? recv.w : obj[1].w;
                    const int rA_ = row - fr + (fr & 7), cc_ = col0 + (lo_ ? 0 : 32);
                    *(GAS v4u*)(hb + (size_t)rA_ * DM + cc_) = dA; *(GAS v4u*)(hb + (size_t)(rA_ + 8) * DM + cc_) = dB; }
                if (!FINAL) { hs = rows4_sum(hs); if (fq == 0) P[(ai * 128 + m * 16 + rl0) * 4 + wc] = hs; }
                if (ai == 0 && (m & 1)) {
#pragma unroll
                    for (int m2 = m - 1; m2 <= m; ++m2)
#pragma unroll
                        for (int bj = 0; bj < 2; ++bj) pre[m2][bj] = *(const GAS v4u*)(hb + (size_t)(row0 + 128 + m2 * 16) * DM + col0 + 32 * bj); } }
        }
        if (!FINAL) {
            asm volatile("s_waitcnt lgkmcnt(0)" ::: "memory"); __builtin_amdgcn_s_barrier(); asm volatile("" ::: "memory");
            if (tid < 256) { const f32x4 p4 = *(const LAS f32x4*)(P + 4 * tid); sqh[(size_t)(u.pm * 256 + tid) * 4 + u.pn] = (p4.x + p4.y) + (p4.z + p4.w); }
        }
        asm volatile("s_waitcnt lgkmcnt(0)" ::: "memory"); __builtin_amdgcn_s_barrier(); asm volatile("" ::: "memory");
    }
};

__device__ __forceinline__ void p2_fold_units(Frame& F, const Args& A, const bf16* kvb, int r, int half) {
            if (r < 4) { const int h = r;
                pg8::Gemm g{kvb + h * 256, WSB(WS_WQ) + h * 256, MEM_LEN, DM, 256, 2048, DM}; pg8::FixedUnit S{0, 2 * half, 0, 2 * half + 1};
                pg8::EpiStore E{WSB(WS_MBT) + (size_t)F.vx * DM * DM + (size_t)(h * 256) * DM, DM, C2_X, nullptr, 0};
                pg8::gemm_phase<pg8::EpiStore, pg8::FixedUnit, GEMM_ALIGN, GEMM_SP2>(F.lds + RING_OFF, g, S, E); }
            else { const int h = r - 4;
                pg8::Gemm g{WSB(WS_WO) + h * 256, kvb + DM + h * 256, DM, MEM_LEN, 256, DM, 2048}; pg8::FixedUnit S{2 * half, 0, 2 * half + 1, 0};
                pg8::EpiStore E{WSB(WS_NBT) + (size_t)F.vx * DM * DM + h * 256, DM, 1.0f, nullptr, 0};
                pg8::gemm_phase<pg8::EpiStore, pg8::FixedUnit, GEMM_ALIGN, GEMM_SP2>(F.lds + RING_OFF, g, S, E); }
}

__global__ void __launch_bounds__(NWAVES * 64, 2) hymba_fwd(Args args) {
    const Args& A = args;
    extern __shared__ __attribute__((aligned(16))) unsigned char lds[];
    Frame F;
    F.lds = (LAS unsigned char*)lds;
    F.MISC = (volatile LAS unsigned*)(F.lds + MISC_OFF);
    F.tid = threadIdx.x; F.lane = F.tid & 63; F.wave = __builtin_amdgcn_readfirstlane(F.tid >> 6);
    F.G = gridDim.x; { const int bx = blockIdx.x; F.vcu = (F.G % 8 == 0) ? (bx % 8) * (F.G / 8) + bx / 8 : bx; }
    unsigned char* ws = args.ws;
    F.ctl = (gu32*)(ws + WS_CTL);
    for (int u = F.tid; u < (LDS_BYTES - LDSCTL_OFF) / 4; u += NWAVES * 64) ((LAS unsigned*)(F.lds + LDSCTL_OFF))[u] = 0u;
    __syncthreads();
    const bool use_bar = true;
    XcdBarrier bar; bar.bar = (unsigned*)(F.ctl + CW_BAR) + args.bar_region * XCD_BAR_WORDS; bar.x = 0; bar.st = nullptr;
    if (use_bar) bar = xcd_barrier_post((unsigned*)(F.ctl + CW_BAR) + args.bar_region * XCD_BAR_WORDS, F.MISC + 8);
    const int lo = args.ph_lo, hi = args.ph_hi;
    F.vx = F.vcu >> 5; F.vr = F.vcu & 31; bool xl = false;
#ifndef ONLY
#define ONLY -1
#endif
#define IN(k) ((ONLY < 0 || ONLY == (k)) && lo <= (k) && (k) < hi)
#define SEAM(k) do { if (IN(k) && IN((k) + 1)) xcd_barrier(bar, xl); } while (0)

    if (IN(0)) { p0_prologue(F, A); }
    if (IN(0) && IN(1)) {
        xcd_barrier(bar, false);
#ifndef FORCE_FALLBACK
        if (F.MISC[10] != 0u) { xl = true; F.vx = (int)__builtin_amdgcn_readfirstlane(bar.x); F.vr = (int)__builtin_amdgcn_readfirstlane(F.MISC[11]); }
#endif
    }
    if (IN(1)) {
        pg8::Gemm g{WSB(WS_XN), WSB(WS_WIN), MTOK, NPROJ, DM}; pg8::HybridOrder S; S.init(MTOK, NPROJ, F.G, (int)blockIdx.x, F.vx, F.vr);
        pg8::EpiStore E{WSB(WS_PROJ), NPROJ, 1.0f, nullptr, 0, 2, 6, COL_CG, COL_KSL / 256, COL_KW / 256 + 1, (const float*)(A.ws + WS_ROPE)};
#if defined(PROBE_DUP) && PROBE_DUP == 30
        pg8::gemm_phase<pg8::EpiStore, pg8::HybridOrder, GEMM_ALIGN, GEMM_SP2>(F.lds + RING_OFF, g, S, E);
#endif
        pg8::gemm_phase<pg8::EpiStore, pg8::HybridOrder, GEMM_ALIGN, GEMM_SP2>(F.lds + RING_OFF, g, S, E);
    } SEAM(1);
    if (IN(2)) {
        if (F.vr >= 8 && F.vr < 24) { compress_unit(F, A, 16 * F.vx + F.vr - 8);
#if defined(PROBE_DUP) && PROBE_DUP == 15
            compress_unit(F, A, 16 * F.vx + F.vr - 8);
#endif
        }
        else {
            const int r = F.vr & 7, half = F.vr >> 4;
            { pg8::Gemm g{WSB(WS_MN), WSB(WS_WKV), MMEM, 2 * DM, DM}; pg8::FixedUnit S{F.vx, r, -1, -1};
              pg8::EpiStore E{WSB(WS_KVX), 2 * DM, 1.0f, nullptr, 0};
              pg8::gemm_phase<pg8::EpiStore, pg8::FixedUnit, GEMM_ALIGN, GEMM_SP2>(F.lds + RING_OFF, g, S, E); }
            asm volatile("s_waitcnt vmcnt(0)" ::: "memory"); __syncthreads();
            const bf16* kvb = WSB(WS_KVX) + (size_t)(F.vx * MEM_LEN) * 2048;
            p2_fold_units(F, A, kvb, r, half);
#if defined(PROBE_DUP) && PROBE_DUP == 14
            p2_fold_units(F, A, kvb, r, half);
#endif
        }
    } SEAM(2);
    if (IN(3)) {
#if defined(PROBE_DUP) && PROBE_DUP == 60
        for (int rep_ = 0; rep_ < 2; ++rep_)
#endif
        for (int p = (F.G == 256 ? F.vx * 32 + F.vr : F.vcu); p < 256; p += F.G) { const int b = p >> 5, s = p & 31;
#pragma nounroll
            for (int h2 = 0; h2 < 2; ++h2) nsa_unit(F, A, b, h2 ? s : 63 - s); }
    } SEAM(3);
#if defined(PROBE_DUP) && PROBE_DUP == 9
    if (IN(4)) { for (int rep_ = 0; rep_ < 8; ++rep_) xcd_barrier(bar); }
#endif
    float* const sqb = (float*)(A.ws + WS_SQ);
    unsigned* const pcnt = (unsigned*)(A.ws + WS_CTL + WS_PCNT) + args.bar_region * 384 * PCNT_STRIDE; unsigned* const tmo = bar.bar + XB_TMO; LAS float* const rtab = (LAS float*)(F.lds + WSF_OFF);
    if (IN(4)) {
        pg8::Gemm g{WSB(WS_MIXED), WSB(WS_WOUT), MTOK, DM, DM}; pg8::HybridOrder S; S.init(MTOK, DM, F.G, (int)blockIdx.x, F.vx, F.vr);
        EpiResid<true, false> E{WSB(WS_H), (const float*)(A.ws + WS_RSTD), INF(15), sqb, sqb + 3 * (SQ_BYTES / 4), nullptr, pcnt, tmo, rtab, xl};
        pg8::gemm_phase<EpiResid<true, false>, pg8::HybridOrder, true, GEMM_SP2, GEMM_A_AUX>(F.lds + RING_OFF, g, S, E);
    } SEAM(4);
    if (IN(6)) {
        pg8::Gemm g{WSB(WS_H), WSB(WS_MBT) + (size_t)F.vx * DM * DM, MTOK, DM, DM}; pg8::HybridOrder S; S.init(MTOK, DM, F.G, (int)blockIdx.x, F.vx, F.vr);
        pg8::EpiSoftmax E{WSB(WS_QX), DM, (LAS float*)(F.lds + WSF_OFF), sqb + 3 * (SQ_BYTES / 4)};
        pg8::gemm_phase<pg8::EpiSoftmax, pg8::HybridOrder, true, GEMM_SP2>(F.lds + RING_OFF, g, S, E);
    } SEAM(6);
    if (IN(8)) {
        pg8::Gemm g{WSB(WS_QX), WSB(WS_NBT) + (size_t)F.vx * DM * DM, MTOK, DM, DM}; pg8::HybridOrder S; S.init(MTOK, DM, F.G, (int)blockIdx.x, F.vx, F.vr);
        EpiResid<false, false> E{WSB(WS_H), nullptr, INF(21), sqb + (SQ_BYTES / 4), sqb + 4 * (SQ_BYTES / 4), nullptr, pcnt + 128 * PCNT_STRIDE, tmo, rtab, xl};
        pg8::gemm_phase<EpiResid<false, false>, pg8::HybridOrder, true, GEMM_SP2, GEMM_A_AUX>(F.lds + RING_OFF, g, S, E);
    } SEAM(8);
#ifdef WARM_W
    if (IN(10)) { warm_buffer(WSB(WS_WGU), (size_t)2 * DFF * DM * 2); warm_buffer(WSB(WS_WD), (size_t)DM * DFF * 2); }
#endif
#ifdef PROBE_SLEEP_US
    if (IN(10)) { const unsigned long long t0_ = __builtin_amdgcn_s_memrealtime(); while (__builtin_amdgcn_s_memrealtime() - t0_ < (unsigned long long)PROBE_SLEEP_US * 100ull) __builtin_amdgcn_s_sleep(64); }
#endif
    if (IN(10)) {
        pg8::Gemm g{WSB(WS_H), WSB(WS_WGU), MTOK, 2 * DFF, DM}; pg8::HybridOrder S; S.init(MTOK, 2 * DFF, F.G, (int)blockIdx.x, F.vx, F.vr);
        pg8::EpiSwiGLU E{{}, -1, sqb + 4 * (SQ_BYTES / 4), WSB(WS_HB) + (size_t)F.vx * HB_BATCH_SHIFT, HB_PITCH};
#if defined(PROBE_DUP) && PROBE_DUP == 11
        for (int rep_ = 0; rep_ < 2; ++rep_)
#endif
        pg8::gemm_phase<pg8::EpiSwiGLU, pg8::HybridOrder, GEMM_ALIGN, GEMM_SP2>(F.lds + RING_OFF, g, S, E);
    } SEAM(10);
#if defined(PROBE_DUP) && PROBE_DUP == 12
    if (IN(11)) {
        pg8::Gemm g{WSB(WS_HB) + (size_t)F.vx * HB_BATCH_SHIFT, WSB(WS_WD), MTOK, DM, DFF, 64, 0}; pg8::HybridOrder S; S.init(MTOK, DM, F.G, (int)blockIdx.x, F.vx, F.vr);
        pg8::EpiStore E{WSB(WS_MBT), DM, 1.0f, nullptr, 0};
        pg8::gemm_phase<pg8::EpiStore, pg8::HybridOrder, GEMM_ALIGN, GEMM_SP2, GEMM_A_AUX_DOWN>(F.lds + RING_OFF, g, S, E);
        xcd_barrier(bar, xl);
    }
#endif
    if (IN(11)) {
        pg8::Gemm g{WSB(WS_HB) + (size_t)F.vx * HB_BATCH_SHIFT, WSB(WS_WD), MTOK, DM, DFF, HB_PITCH, 0};
        pg8::HybridOrder S; S.init(MTOK, DM, F.G, (int)blockIdx.x, F.vx, F.vr);
        EpiResid<false, true> E{WSB(WS_H), nullptr, INF(25), sqb + 2 * (SQ_BYTES / 4), nullptr, A.out, pcnt + 256 * PCNT_STRIDE, tmo, rtab, xl};
        pg8::gemm_phase<EpiResid<false, true>, pg8::HybridOrder, true, GEMM_SP2, GEMM_A_AUX_DOWN>(F.lds + RING_OFF, g, S, E);
    }
#undef IN
#undef SEAM
}

#ifndef MK_MULTI
#define MK_MULTI 0
#endif
extern "C" void kernel_launch(void* const* d_in, const int* in_sizes, int n_in, void* d_out, int out_size, void* d_ws, size_t ws_size, hipStream_t stream) {
    static int grid = 0;
    if (grid == 0) {
        if (n_in != 26 || in_sizes[0] != MTOK * DM || out_size != MTOK * DM || ws_size < WS_END) { fprintf(stderr, "kernel_launch: unexpected shapes (n_in %d, in0 %d, out %d, ws %zu); nothing launched\n", n_in, n_in > 0 ? in_sizes[0] : -1, out_size, ws_size); grid = -1; return; }
        int dev = 0, cus = 0, per_cu = 0;
        if (hipGetDevice(&dev) != hipSuccess || hipDeviceGetAttribute(&cus, hipDeviceAttributeMultiprocessorCount, dev) != hipSuccess) { grid = -1; return; }
        if (hipFuncSetAttribute((const void*)hymba_fwd, hipFuncAttributeMaxDynamicSharedMemorySize, LDS_BYTES) != hipSuccess) { fprintf(stderr, "kernel_launch: hipFuncSetAttribute failed\n"); grid = -1; return; }
        if (hipOccupancyMaxActiveBlocksPerMultiprocessor(&per_cu, (const void*)hymba_fwd, NWAVES * 64, LDS_BYTES) != hipSuccess || per_cu < 1)
            fprintf(stderr, "kernel_launch: note: occupancy query reports %d workgroups per CU\n", per_cu);
        (void)hipGetLastError();
        if (cus != 256) { fprintf(stderr, "kernel_launch: built for a 256-CU device (8 XCCs x 32), found %d CUs; nothing launched\n", cus); grid = -1; return; }
        grid = cus;
    }
    if (grid < 0) return;
    if (hipMemsetAsync((char*)d_ws + WS_CTL, 0, CTL_ZERO_BYTES, stream) != hipSuccess) { fprintf(stderr, "kernel_launch: hipMemsetAsync failed\n"); return; }
    Args a{};
    for (int i = 0; i < 26; ++i) a.in[i] = d_in[i];
    a.out = (float*)d_out; a.ws = (unsigned char*)d_ws;
#if MK_MULTI
    for (int p = 0; p < N_PHASES; ++p) { a.ph_lo = p; a.ph_hi = p + 1; a.bar_region = p; hipLaunchKernelGGL(hymba_fwd, dim3(grid), dim3(NWAVES * 64), LDS_BYTES, stream, a); }
#elif defined(CUM_PHASE)
    a.ph_lo = 0; a.ph_hi = CUM_PHASE + 1; a.bar_region = 0; hipLaunchKernelGGL(hymba_fwd, dim3(grid), dim3(NWAVES * 64), LDS_BYTES, stream, a);
    a.ph_lo = 0; a.ph_hi = N_PHASES; a.bar_region = 1; hipLaunchKernelGGL(hymba_fwd, dim3(grid), dim3(NWAVES * 64), LDS_BYTES, stream, a);
#elif defined(REP_PHASE)
    a.ph_lo = 0; a.ph_hi = REP_PHASE + 1; a.bar_region = 0; hipLaunchKernelGGL(hymba_fwd, dim3(grid), dim3(NWAVES * 64), LDS_BYTES, stream, a);
    a.ph_lo = REP_PHASE; a.ph_hi = REP_PHASE + 1; a.bar_region = 1; hipLaunchKernelGGL(hymba_fwd, dim3(grid), dim3(NWAVES * 64), LDS_BYTES, stream, a);
    a.ph_lo = REP_PHASE + 1; a.ph_hi = N_PHASES; a.bar_region = 2; hipLaunchKernelGGL(hymba_fwd, dim3(grid), dim3(NWAVES * 64), LDS_BYTES, stream, a);
#else
    a.ph_lo = 0; a.ph_hi = N_PHASES;
    hipLaunchKernelGGL(hymba_fwd, dim3(grid), dim3(NWAVES * 64), LDS_BYTES, stream, a);
#endif
    const hipError_t le = hipPeekAtLastError();
    if (le != hipSuccess) fprintf(stderr, "kernel_launch: launch failed: %s\n", hipGetErrorName(le));
}
```
